# Optimizing an MI355X kernel written in HIP

```python
import jax, jax.numpy as jnp
from jax import lax
import numpy as np

D_MODEL = 2048
BATCH = 2
SEQ = 4096
DEPTH = 1

CHUNK = 64
N_META = 16
ATT_HEADS = 16
ATT_HEAD_DIM = 128
ATT_WIDTH = ATT_HEADS * ATT_HEAD_DIM
CONV_WIDTH = D_MODEL
CONV_GROUPS = 16
CONV_K = 3
Q_BLOCK = 128
EPS = 1e-6
_IN_SIZES = (ATT_WIDTH, ATT_WIDTH, ATT_WIDTH, ATT_HEADS, ATT_WIDTH,
             CONV_WIDTH, CONV_WIDTH, CONV_WIDTH, CONV_WIDTH, D_MODEL, D_MODEL)
N_IN = 4 * ATT_WIDTH + ATT_HEADS + 4 * CONV_WIDTH + 2 * D_MODEL

kernel_name = "fox_shortconv_gated_hybrid_block"


def _split_points():
    pts, acc = [], 0
    for s in _IN_SIZES[:-1]:
        acc += s
        pts.append(acc)
    return pts


def rmsnorm(x, g):
    xf = x.astype(jnp.float32)
    y = xf * lax.rsqrt(jnp.mean(xf * xf, axis=-1, keepdims=True) + EPS)
    return (y * g.astype(jnp.float32)).astype(x.dtype)


def forgetting_attention(q, k, v, log_f):
    b, l, h, dh = q.shape
    nb = l // Q_BLOCK
    c = jnp.cumsum(log_f, axis=1).transpose(0, 2, 1)
    scale = dh ** -0.5
    kpos = jnp.arange(l)
    q_blocks = q.reshape(b, nb, Q_BLOCK, h, dh).transpose(1, 0, 3, 2, 4)
    c_blocks = c.reshape(b, h, nb, Q_BLOCK).transpose(2, 0, 1, 3)
    starts = jnp.arange(nb) * Q_BLOCK

    def one_block(args):
        q_blk, c_blk, start = args
        s = jnp.einsum('bhqd,bkhd->bhqk', q_blk, k).astype(jnp.float32) * scale
        s = s + (c_blk[..., None] - c[:, :, None, :])
        qpos = start + jnp.arange(Q_BLOCK)
        causal = kpos[None, :] <= qpos[:, None]
        p = jax.nn.softmax(jnp.where(causal, s, -jnp.inf), axis=-1)
        return jnp.einsum('bhqk,bkhd->bqhd', p.astype(v.dtype), v)

    out = lax.map(one_block, (q_blocks, c_blocks, starts))
    return out.transpose(1, 0, 2, 3, 4).reshape(b, l, h * dh)


def short_conv(u, w):
    l = u.shape[1]
    up = jnp.pad(u, ((0, 0), (CONV_K - 1, 0), (0, 0)))
    out = up[:, 0:l] * w[0]
    for j in range(1, CONV_K):
        out = out + up[:, j:j + l] * w[j]
    return out


def hybrid_layer(x, norm_g, w_in, b_f, conv_w, w_att_o, w_conv_o, w_out):
    b, l, _ = x.shape
    h = rmsnorm(x, norm_g)
    proj = jnp.einsum('bld,dn->bln', h, w_in)
    (q, k, v, f_logit, z_att, u, gate_b, gate_c, z_conv,
     m_att, m_conv) = jnp.split(proj, _split_points(), axis=-1)
    heads = lambda t: t.reshape(b, l, ATT_HEADS, ATT_HEAD_DIM)
    log_f = jax.nn.log_sigmoid((f_logit + b_f).astype(jnp.float32))
    o_att = forgetting_attention(heads(q), heads(k), heads(v), log_f)
    y_att = jnp.einsum('blc,cd->bld', o_att * jax.nn.silu(z_att), w_att_o)
    o_conv = gate_b * short_conv(gate_c * u, conv_w)
    y_conv = jnp.einsum('blc,cd->bld', o_conv * jax.nn.silu(z_conv), w_conv_o)
    merged = jax.nn.sigmoid(m_att) * y_att + jax.nn.sigmoid(m_conv) * y_conv
    return x + jnp.einsum('bld,de->ble', merged, w_out)


def setup_inputs(seed: int = 0) -> dict:
    key = jax.random.key(seed)
    ks = jax.random.split(key, 11)
    f32 = jnp.float32
    x = jax.random.normal(ks[0], (BATCH, SEQ, D_MODEL), f32)
    meta_tokens = jax.random.normal(ks[1], (N_META, D_MODEL), f32)
    norm_gain = 1.0 + 0.01 * jax.random.normal(ks[2], (DEPTH, D_MODEL), f32)
    w_in = jax.random.normal(ks[3], (DEPTH, D_MODEL, N_IN), f32) * D_MODEL ** -0.5
    b_f = (jnp.linspace(1.0, 6.0, ATT_HEADS, dtype=f32)[None, :]
           + 0.1 * jax.random.normal(ks[4], (DEPTH, ATT_HEADS), f32))
    conv_w = jax.random.normal(ks[5], (DEPTH, CONV_K, CONV_WIDTH), f32) * CONV_K ** -0.5
    w_att_o = jax.random.normal(ks[6], (DEPTH, ATT_WIDTH, D_MODEL), f32) * ATT_WIDTH ** -0.5
    w_conv_o = jax.random.normal(ks[7], (DEPTH, CONV_WIDTH, D_MODEL), f32) * CONV_WIDTH ** -0.5
    w_out = jax.random.normal(ks[8], (DEPTH, D_MODEL, D_MODEL), f32) * D_MODEL ** -0.5
    final_gain = 1.0 + 0.01 * jax.random.normal(ks[9], (D_MODEL,), f32)
    return {"x": x, "meta_tokens": meta_tokens, "norm_gain": norm_gain, "w_in": w_in,
            "b_f": b_f, "conv_w": conv_w, "w_att_o": w_att_o, "w_conv_o": w_conv_o,
            "w_out": w_out, "final_gain": final_gain}


def reference(x, meta_tokens, norm_gain, w_in, b_f, conv_w, w_att_o, w_conv_o, w_out, final_gain):
    b = x.shape[0]
    l_real = N_META + x.shape[1]
    l_pad = -(-l_real // Q_BLOCK) * Q_BLOCK
    meta = jnp.broadcast_to(meta_tokens.astype(x.dtype)[None], (b, N_META, D_MODEL))
    hdn = jnp.concatenate([meta, x], axis=1)
    hdn = jnp.pad(hdn, ((0, 0), (0, l_pad - l_real), (0, 0)))
    for i in range(DEPTH):
        hdn = hybrid_layer(hdn, norm_gain[i], w_in[i], b_f[i], conv_w[i],
                           w_att_o[i], w_conv_o[i], w_out[i])
    hdn = rmsnorm(hdn, final_gain)
    return hdn[:, N_META:l_real]
```

```cpp
#include <hip/hip_runtime.h>
#include <hip/hip_cooperative_groups.h>
#include <cstdio>
#include <cstdint>
namespace cg = cooperative_groups;

#ifndef PROBE_REPEAT
#define PROBE_REPEAT -1
#endif
#ifndef SIDE_REPS
#define SIDE_REPS 1
#endif
#ifndef MK_COOP
#define MK_COOP 1
#endif

#define LAS __attribute__((address_space(3)))
typedef unsigned short bf16_t;
typedef short bf16x8 __attribute__((ext_vector_type(8)));
typedef short s16x4 __attribute__((ext_vector_type(4)));
typedef float f32x4 __attribute__((ext_vector_type(4)));
typedef float f32x2 __attribute__((ext_vector_type(2)));
typedef float f32x16 __attribute__((ext_vector_type(16)));
typedef unsigned u32x4 __attribute__((ext_vector_type(4)));
typedef unsigned u32x2 __attribute__((ext_vector_type(2)));

constexpr int DM = 2048, NB = 2, SEQ = 4096, NMETA = 16, NH = 16, HD = 128;
constexpr int MREAL = NB * SEQ;
constexpr int MALL = MREAL + 256;
constexpr int N_IN = 20496;
constexpr int NPROJ = 81 * 256;
constexpr int KVROWS = 64 + SEQ;
constexpr int P1ROWS = 2 + SEQ;
constexpr float EPS = 1e-6f;
constexpr float LOG2E = 1.4426950408889634f;
constexpr float QSCALE = 0.08838834764831845f * 1.4426950408889634f;

constexpr size_t MiB = 1u << 20;
constexpr size_t WS_WIN = 0, WS_WATT = 81 * MiB, WS_WCONV = 89 * MiB, WS_WOUT = 97 * MiB, WS_XN = 105 * MiB, WS_Q = 138 * MiB,
                 WS_K = 170 * MiB, WS_V = 203 * MiB, WS_Z = 236 * MiB, WS_P1 = 268 * MiB, WS_P2 = 301 * MiB, WS_R = 333 * MiB,
                 WS_S2 = 365 * MiB, WS_AATT = 397 * MiB, WS_ACONV = 429 * MiB, WS_MG = 461 * MiB, WS_LF = 493 * MiB, WS_SS = 494 * MiB,
                 WS_CTL = 495 * MiB, WS_END = 496 * MiB;

__device__ __forceinline__ unsigned cvt_pk_bf16(float lo, float hi) { unsigned r; asm volatile("v_cvt_pk_bf16_f32 %0, %1, %2" : "=v"(r) : "v"(lo), "v"(hi)); return r; }
__device__ __forceinline__ float bf_lo(unsigned w) { return __uint_as_float(w << 16); }
__device__ __forceinline__ float bf_hi(unsigned w) { return __uint_as_float(w & 0xffff0000u); }
__device__ __forceinline__ float sigmoidf_(float x) { return __builtin_amdgcn_rcpf(1.0f + __expf(-x)); }
__device__ __forceinline__ float siluf_(float x) { return x * sigmoidf_(x); }

namespace pg8 {
constexpr int BM = 256, BK = 64, HALF = 128, HTB = HALF * BK * 2, STAGE_BYTES = 8 * HTB, NXCD = 8, WGM = 8;
__host__ __device__ __forceinline__ int lds_byte(int r, int c) { const int st = (r >> 4) * 2 + (c >> 5), rr = r & 15, cc = c & 31, ob = rr * 64 + cc * 2; return st * 1024 + (ob ^ (((ob >> 9) & 1) << 5)); }
__host__ __device__ __forceinline__ void stage_rc(int b, int& R, int& C) { const int st = b / 1024, sb = b % 1024, swz = sb ^ (((sb >> 9) & 1) << 5); R = (st >> 1) * 16 + swz / 64; C = (st & 1) * 32 + (swz % 64) / 2; }
__host__ __device__ __forceinline__ int perm32(int rho) { const int n = rho >> 4, i = rho & 15; return 8 * (i >> 2) + 4 * n + (i & 3); }

struct Unit { int pm, pn, seg; };
struct Gemm { const bf16_t* A; const bf16_t* Bt; const bf16_t* A2; const bf16_t* Bt2; int M, N, K; };

template <int NSEG> struct StaticOrder {
    int nM, nN, nwg, G, c;
    __device__ void init(int M, int N, int G_, int c_) { nM = M / BM; nN = N / BM; nwg = nM * nN; G = G_; c = c_; }
    __device__ bool next(int i, Unit& u) const {
        const int ti = (NSEG == 2) ? (i >> 1) : i; u.seg = (NSEG == 2) ? (i & 1) : 0;
        const long L = (long)ti * G + c; if (L >= nwg) return false;
        int wgid = (int)L; { const int q = nwg / NXCD, r = nwg % NXCD, xcd = wgid % NXCD, off = wgid / NXCD; wgid = (xcd < r ? xcd * (q + 1) : r * (q + 1) + (xcd - r) * q) + off; }
        const int nig = WGM * nN, gid = wgid / nig, fm = gid * WGM, gsz = (nM - fm) < WGM ? (nM - fm) : WGM;
        u.pm = fm + ((wgid % nig) % gsz); u.pn = (wgid % nig) / gsz; return true;
    }
};

typedef f32x4 Acc[2][2][4][2];

template <class Epi, class Sched, int NSEG, bool ALIGN_EPI = true, bool AFTER_DRAIN = false>
__device__ __forceinline__ void gemm_phase(LAS unsigned char* lds, const Gemm g, const Sched& S, const Epi& E) {
    const int tid = threadIdx.x, wid = __builtin_amdgcn_readfirstlane(tid >> 6), lane = tid & 63, wr = wid >> 2, wc = wid & 3, fr = lane & 15, fq = lane >> 4;
    const int K = g.K, nt = K / BK;
    unsigned voffA[2], voffB[2];
#pragma unroll
    for (int i = 0; i < 2; ++i) { int R, C; stage_rc(tid * 16 + i * 8192, R, C); const int Rb = Epi::PERM ? ((R & ~31) + perm32(R & 31)) : R;
        voffA[i] = (unsigned)(R * K + C) * 2u; voffB[i] = (unsigned)(Rb * K + C) * 2u; }
    const size_t kstep = (size_t)(BK * 2);
    const size_t hstep = (size_t)HALF * K * 2;
    const size_t tstep = 2 * hstep;
    const unsigned ldsw = (unsigned)wid * 1024u;
    const int aoff = lds_byte(wr * 64 + fr, fq * 8), boff = lds_byte(wc * 32 + fr, fq * 8);
#define PG8_SA(b, h) (((b) * 2 + (h)) * HTB)
#define PG8_SB(b, h) ((4 + (b) * 2 + (h)) * HTB)
#define PG8_STAGE(bufoff, gbase, voff) do { _Pragma("unroll") for (int _i = 0; _i < 2; ++_i) \
        __builtin_amdgcn_global_load_lds((const unsigned*)((const char*)(gbase) + (voff)[_i]), (LAS unsigned*)(lds + (bufoff) + ldsw + _i * 8192), 16, 0, 0); } while (0)
#define PG8_LDA(dst, b, h) do { _Pragma("unroll") for (int m = 0; m < 4; ++m) _Pragma("unroll") for (int k = 0; k < 2; ++k) dst[m][k] = *(const LAS bf16x8*)(lds + PG8_SA(b, h) + aoff + m * 2048 + k * 1024); } while (0)
#define PG8_LDB(dst, b, h) do { _Pragma("unroll") for (int n = 0; n < 2; ++n) _Pragma("unroll") for (int k = 0; k < 2; ++k) dst[n][k] = *(const LAS bf16x8*)(lds + PG8_SB(b, h) + boff + n * 2048 + k * 1024); } while (0)
#define PG8_MMA(ai, bj, At, Bt) do { __builtin_amdgcn_s_setprio(1); _Pragma("unroll") for (int m = 0; m < 4; ++m) _Pragma("unroll") for (int n = 0; n < 2; ++n) _Pragma("unroll") for (int k = 0; k < 2; ++k) \
        acc[ai][bj][m][n] = __builtin_amdgcn_mfma_f32_16x16x32_bf16(Bt[n][k], At[m][k], acc[ai][bj][m][n], 0, 0, 0); __builtin_amdgcn_s_setprio(0); } while (0)
#define PG8_WAIT_V(n) asm volatile("s_waitcnt vmcnt(" #n ")" ::: "memory")
#define PG8_WAIT_L(n) asm volatile("s_waitcnt lgkmcnt(" #n ")" ::: "memory")
#define PG8_BAR __builtin_amdgcn_s_barrier()
#define PG8_SCHED __builtin_amdgcn_sched_barrier(0)
#define PG8_ABASE(u) ((const char*)(((NSEG == 2) && (u).seg) ? g.A2 : g.A) + (size_t)(u).pm * tstep)
#define PG8_BBASE(u) ((const char*)(((NSEG == 2) && (u).seg) ? g.Bt2 : g.Bt) + (size_t)(u).pn * tstep)
    Unit cur, nxt; int ui = 0;
    if (!S.next(0, cur)) return;
    f32x4 acc[2][2][4][2];
#pragma unroll
    for (int a = 0; a < 2; ++a)
#pragma unroll
        for (int b = 0; b < 2; ++b)
#pragma unroll
            for (int m = 0; m < 4; ++m)
#pragma unroll
                for (int n = 0; n < 2; ++n) acc[a][b][m][n] = (f32x4){0.f, 0.f, 0.f, 0.f};
    bf16x8 At[4][2], B0[2][2], B1[2][2];
    const char* cA = PG8_ABASE(cur); const char* cB = PG8_BBASE(cur);
    PG8_STAGE(PG8_SB(0, 0), cB, voffB); PG8_STAGE(PG8_SB(0, 1), cB + hstep, voffB); PG8_STAGE(PG8_SA(0, 0), cA, voffA); PG8_STAGE(PG8_SA(0, 1), cA + hstep, voffA);
    if (wr == 1) PG8_BAR;
    PG8_WAIT_V(2); PG8_BAR;
    PG8_STAGE(PG8_SB(1, 0), cB + kstep, voffB); PG8_STAGE(PG8_SA(1, 0), cA + kstep, voffA); PG8_STAGE(PG8_SB(1, 1), cB + hstep + kstep, voffB);
    PG8_WAIT_V(6); PG8_BAR;
    for (;;) {
        const bool has_next = S.next(ui + 1, nxt);
        const char* nA = has_next ? PG8_ABASE(nxt) : cA; const char* nB = has_next ? PG8_BBASE(nxt) : cB;
        for (int t = 0; t < nt; t += 2) {
            const bool last = (t == nt - 2);
            const char* a1 = cA + (size_t)(t + 1) * kstep;
            const char* a2 = last ? nA : cA + (size_t)(t + 2) * kstep; const char* b2 = last ? nB : cB + (size_t)(t + 2) * kstep;
            const char* a3 = a2 + kstep; const char* b3 = b2 + kstep;
            PG8_LDB(B0, 0, 0); PG8_LDB(B1, 0, 1); PG8_SCHED; PG8_LDA(At, 0, 0); PG8_STAGE(PG8_SA(1, 1), a1 + hstep, voffA);
            PG8_WAIT_V(8); PG8_WAIT_L(0); PG8_BAR; PG8_MMA(0, 0, At, B0); PG8_MMA(0, 1, At, B1); PG8_BAR; PG8_SCHED;
            PG8_LDA(At, 0, 1); PG8_STAGE(PG8_SB(0, 0), b2, voffB); PG8_STAGE(PG8_SB(0, 1), b2 + hstep, voffB); PG8_STAGE(PG8_SA(0, 0), a2, voffA);
            PG8_WAIT_V(8); PG8_WAIT_L(0); PG8_BAR; PG8_MMA(1, 0, At, B0); PG8_MMA(1, 1, At, B1); PG8_BAR; PG8_SCHED;
            PG8_LDB(B0, 1, 0); PG8_LDB(B1, 1, 1); PG8_SCHED; PG8_LDA(At, 1, 0); PG8_STAGE(PG8_SA(0, 1), a2 + hstep, voffA);
            PG8_WAIT_V(8); PG8_WAIT_L(0); PG8_BAR; PG8_MMA(0, 0, At, B0); PG8_MMA(0, 1, At, B1); PG8_BAR; PG8_SCHED;
            PG8_LDA(At, 1, 1); PG8_STAGE(PG8_SB(1, 0), b3, voffB); PG8_STAGE(PG8_SB(1, 1), b3 + hstep, voffB); PG8_STAGE(PG8_SA(1, 0), a3, voffA);
            PG8_WAIT_V(8); PG8_WAIT_L(0); PG8_BAR; PG8_MMA(1, 0, At, B0); PG8_MMA(1, 1, At, B1); PG8_BAR; PG8_SCHED;
        }
        if constexpr (ALIGN_EPI) { if (wr == 0) PG8_BAR; }
        const bool midseg = (NSEG == 2) && (cur.seg == 0);
        if (midseg) E.mid(acc, cur, wr, wc, fr, fq); else if constexpr (!AFTER_DRAIN) E(acc, cur, wr, wc, fr, fq);
        if (!has_next) break;
        if (!midseg) {
#pragma unroll
            for (int a = 0; a < 2; ++a)
#pragma unroll
                for (int b = 0; b < 2; ++b)
#pragma unroll
                    for (int m = 0; m < 4; ++m)
#pragma unroll
                        for (int n = 0; n < 2; ++n) acc[a][b][m][n] = (f32x4){0.f, 0.f, 0.f, 0.f};
        }
        cur = nxt; cA = nA; cB = nB; ++ui;
        if constexpr (ALIGN_EPI) { if (wr == 1) PG8_BAR; }
    }
    PG8_WAIT_V(0);
    if constexpr (!ALIGN_EPI) { if (wr == 0) PG8_BAR; }
    PG8_BAR;
    if constexpr (AFTER_DRAIN) E.fused(acc, cur, wr, wc, fr, fq, lds, wid, lane);
#undef PG8_SA
#undef PG8_SB
#undef PG8_STAGE
#undef PG8_LDA
#undef PG8_LDB
#undef PG8_MMA
#undef PG8_WAIT_V
#undef PG8_WAIT_L
#undef PG8_BAR
#undef PG8_SCHED
#undef PG8_ABASE
#undef PG8_BBASE
}

__device__ __forceinline__ u32x4 pack8(f32x4 v0, f32x4 v1) { u32x4 w; w.x = cvt_pk_bf16(v0[0], v0[1]); w.y = cvt_pk_bf16(v0[2], v0[3]); w.z = cvt_pk_bf16(v1[0], v1[1]); w.w = cvt_pk_bf16(v1[2], v1[3]); return w; }

struct EpiProj {
    static constexpr bool PERM = true;
    bf16_t *Q, *K, *V, *Z, *P1, *P2, *R, *S2;
    __device__ __forceinline__ void mid(Acc&, const Unit&, int, int, int, int) const {}
    __device__ __forceinline__ void operator()(const Acc& acc, const Unit& u, int wr, int wc, int fr, int fq) const {
        const int pm = u.pm, pn = u.pn; const int b = pm >> 4;
        const int rloc = wr * 64 + fr, cl = wc * 32 + 8 * fq;
        if (pn < 32) {
            const int kind = pn >> 3, colt = (pn & 7) * 256 + cl;
            if (kind == 0 || kind == 3) {
                bf16_t* base = (kind == 0 ? Q : Z) + (size_t)(pm * 256 + rloc) * DM + colt;
#pragma unroll
                for (int ai = 0; ai < 2; ++ai)
#pragma unroll
                    for (int m = 0; m < 4; ++m)
#pragma unroll
                        for (int bj = 0; bj < 2; ++bj) { f32x4 v0 = acc[ai][bj][m][0], v1 = acc[ai][bj][m][1];
                            if (kind == 0) { v0 = v0 * QSCALE; v1 = v1 * QSCALE; }
                            else {
#pragma unroll
                                for (int j = 0; j < 4; ++j) { v0[j] = siluf_(v0[j]); v1[j] = siluf_(v1[j]); } }
                            __builtin_nontemporal_store(pack8(v0, v1), (u32x4*)(base + (size_t)(ai * 128 + m * 16) * DM + bj * 128)); }
            } else {
                bf16_t* base = (kind == 1 ? K : V) + ((size_t)(b * NH + 2 * (pn & 7)) * KVROWS + 64 + (pm & 15) * 256 + rloc) * HD + cl;
#pragma unroll
                for (int ai = 0; ai < 2; ++ai)
#pragma unroll
                    for (int m = 0; m < 4; ++m)
#pragma unroll
                        for (int bj = 0; bj < 2; ++bj) *(u32x4*)(base + (size_t)bj * KVROWS * HD + (size_t)(ai * 128 + m * 16) * HD) = pack8(acc[ai][bj][m][0], acc[ai][bj][m][1]);
            }
        } else {
            const int kind = (pn - 32) >> 4, p = (pn - 32) & 15, col = p * 128 + cl;
            if (kind == 0) {
                bf16_t* base = P1 + (size_t)(pm * 256 + 2 + 2 * b + rloc) * DM + col;
#pragma unroll
                for (int ai = 0; ai < 2; ++ai)
#pragma unroll
                    for (int m = 0; m < 4; ++m) __builtin_nontemporal_store(pack8(acc[ai][0][m][0] * acc[ai][1][m][0], acc[ai][0][m][1] * acc[ai][1][m][1]), (u32x4*)(base + (size_t)(ai * 128 + m * 16) * DM));
            } else if (kind == 1) {
                bf16_t* base = P2 + (size_t)(pm * 256 + rloc) * DM + col;
#pragma unroll
                for (int ai = 0; ai < 2; ++ai)
#pragma unroll
                    for (int m = 0; m < 4; ++m) { f32x4 v0, v1;
#pragma unroll
                        for (int j = 0; j < 4; ++j) { v0[j] = acc[ai][0][m][0][j] * siluf_(acc[ai][1][m][0][j]); v1[j] = acc[ai][0][m][1][j] * siluf_(acc[ai][1][m][1][j]); }
                        __builtin_nontemporal_store(pack8(v0, v1), (u32x4*)(base + (size_t)(ai * 128 + m * 16) * DM)); }
            } else {
                const size_t o0 = (size_t)(pm * 256 + rloc) * DM + col;
#pragma unroll
                for (int ai = 0; ai < 2; ++ai)
#pragma unroll
                    for (int m = 0; m < 4; ++m) { f32x4 r0, r1, s0, s1;
#pragma unroll
                        for (int j = 0; j < 4; ++j) { const float e1a = 1.0f + __expf(-acc[ai][0][m][0][j]), e2a = 1.0f + __expf(-acc[ai][1][m][0][j]);
                            const float e1b = 1.0f + __expf(-acc[ai][0][m][1][j]), e2b = 1.0f + __expf(-acc[ai][1][m][1][j]);
                            s0[j] = __builtin_amdgcn_rcpf(e2a); s1[j] = __builtin_amdgcn_rcpf(e2b); r0[j] = e2a * __builtin_amdgcn_rcpf(e1a); r1[j] = e2b * __builtin_amdgcn_rcpf(e1b); }
                        const size_t o = o0 + (size_t)(ai * 128 + m * 16) * DM;
                        __builtin_nontemporal_store(pack8(r0, r1), (u32x4*)(R + o)); __builtin_nontemporal_store(pack8(s0, s1), (u32x4*)(S2 + o)); }
            }
        }
    }
};

struct EpiMerge {
    static constexpr bool PERM = true;
    const bf16_t *R, *S2; bf16_t* MG;
    __device__ __forceinline__ void mid(Acc& acc, const Unit& u, int wr, int wc, int fr, int fq) const {
        const bf16_t* base = R + (size_t)(u.pm * 256 + wr * 64 + fr) * DM + u.pn * 256 + wc * 32 + 8 * fq;
#pragma unroll
        for (int ai = 0; ai < 2; ++ai)
#pragma unroll
            for (int m = 0; m < 4; ++m)
#pragma unroll
                for (int bj = 0; bj < 2; ++bj) { const u32x4 w = __builtin_nontemporal_load((const u32x4*)(base + (size_t)(ai * 128 + m * 16) * DM + bj * 128));
                    acc[ai][bj][m][0] *= (f32x4){bf_lo(w.x), bf_hi(w.x), bf_lo(w.y), bf_hi(w.y)}; acc[ai][bj][m][1] *= (f32x4){bf_lo(w.z), bf_hi(w.z), bf_lo(w.w), bf_hi(w.w)}; }
    }
    __device__ __forceinline__ void operator()(const Acc& acc, const Unit& u, int wr, int wc, int fr, int fq) const {
        const size_t o0 = (size_t)(u.pm * 256 + wr * 64 + fr) * DM + u.pn * 256 + wc * 32 + 8 * fq;
#pragma unroll
        for (int ai = 0; ai < 2; ++ai)
#pragma unroll
            for (int m = 0; m < 4; ++m)
#pragma unroll
                for (int bj = 0; bj < 2; ++bj) { const size_t o = o0 + (size_t)(ai * 128 + m * 16) * DM + bj * 128; const u32x4 w = __builtin_nontemporal_load((const u32x4*)(S2 + o));
                    const f32x4 v0 = acc[ai][bj][m][0] * (f32x4){bf_lo(w.x), bf_hi(w.x), bf_lo(w.y), bf_hi(w.y)}, v1 = acc[ai][bj][m][1] * (f32x4){bf_lo(w.z), bf_hi(w.z), bf_lo(w.w), bf_hi(w.w)};
                    *(u32x4*)(MG + o) = pack8(v0, v1); }
    }
};

struct EpiOut {
    static constexpr bool PERM = false;
    const float* x; float* out; float* SS;
    __device__ __forceinline__ void mid(Acc&, const Unit&, int, int, int, int) const {}
    __device__ __forceinline__ void operator()(const Acc& acc, const Unit& u, int wr, int wc, int fr, int fq) const {
        const size_t o0 = (size_t)(u.pm * 256 + wr * 64 + fr) * DM + u.pn * 256 + wc * 32 + 4 * fq;
#pragma unroll
        for (int ai = 0; ai < 2; ++ai)
#pragma unroll
            for (int m = 0; m < 4; ++m) { float s = 0.f; const size_t o = o0 + (size_t)(ai * 128 + m * 16) * DM;
#pragma unroll
                for (int bj = 0; bj < 2; ++bj)
#pragma unroll
                    for (int n = 0; n < 2; ++n) { const f32x4 y = *(const f32x4*)(x + o + bj * 128 + n * 16) + acc[ai][bj][m][n];
                        s += (y[0] * y[0] + y[1] * y[1]) + (y[2] * y[2] + y[3] * y[3]); *(f32x4*)(out + o + bj * 128 + n * 16) = y; }
                s += __shfl_xor(s, 16); s += __shfl_xor(s, 32);
                if (fq == 0) SS[(size_t)(u.pm * 256 + wr * 64 + fr + ai * 128 + m * 16) * 32 + u.pn * 4 + wc] = s; }
    }
};
struct EpiOutNorm {
    static constexpr bool PERM = false;
    const float* x; float* out; const float* gain; float* xbuf; unsigned* cnt;
    __device__ __forceinline__ void mid(Acc&, const Unit&, int, int, int, int) const {}
    __device__ __forceinline__ void operator()(const Acc&, const Unit&, int, int, int, int) const {}
    __device__ __forceinline__ void fused(Acc& acc, const Unit& u, int wr, int wc, int fr, int fq, LAS unsigned char* lds, int wid, int lane) const {
        LAS float* P = (LAS float*)lds;
        LAS float* S = (LAS float*)(lds + 8192);
        const size_t o0 = (size_t)(u.pm * 256 + wr * 64 + fr) * DM + u.pn * 256 + wc * 32 + 4 * fq;
#pragma unroll
        for (int ai = 0; ai < 2; ++ai)
#pragma unroll
            for (int m = 0; m < 4; ++m) { float s = 0.f; const size_t o = o0 + (size_t)(ai * 128 + m * 16) * DM;
#pragma unroll
                for (int bj = 0; bj < 2; ++bj)
#pragma unroll
                    for (int n = 0; n < 2; ++n) { const f32x4 y = __builtin_nontemporal_load((const f32x4*)(x + o + bj * 128 + n * 16)) + acc[ai][bj][m][n]; acc[ai][bj][m][n] = y;
                        s += (y[0] * y[0] + y[1] * y[1]) + (y[2] * y[2] + y[3] * y[3]); }
                s += __shfl_xor(s, 16); s += __shfl_xor(s, 32);
                if (fq == 0) P[(ai * 128 + wr * 64 + m * 16 + fr) * 4 + wc] = s; }
        asm volatile("s_waitcnt lgkmcnt(0)" ::: "memory"); __builtin_amdgcn_s_barrier(); asm volatile("" ::: "memory");
        const int row = wid * 32 + (lane & 31);
        if (lane < 32) { const float t = (P[row * 4 + 0] + P[row * 4 + 1]) + (P[row * 4 + 2] + P[row * 4 + 3]);
            __hip_atomic_store(xbuf + (size_t)(u.pm * 256 + row) * 8 + u.pn, t, __ATOMIC_RELAXED, __HIP_MEMORY_SCOPE_AGENT); }
        asm volatile("s_waitcnt vmcnt(0)" ::: "memory");
        if (lane == 0) __hip_atomic_fetch_add(cnt + 64 * u.pm, 1u, __ATOMIC_RELAXED, __HIP_MEMORY_SCOPE_AGENT);
        if (wid == 0) {
            while ((unsigned)__builtin_amdgcn_readfirstlane(__hip_atomic_load(cnt + 64 * u.pm, __ATOMIC_RELAXED, __HIP_MEMORY_SCOPE_AGENT)) < 64u) __builtin_amdgcn_s_sleep(2);
            __builtin_amdgcn_fence(__ATOMIC_ACQUIRE, "agent");
        }
        asm volatile("s_waitcnt vmcnt(0) lgkmcnt(0)" ::: "memory"); __builtin_amdgcn_s_barrier(); asm volatile("" ::: "memory");
        if (lane < 32) { const float* slot = xbuf + (size_t)(u.pm * 256 + row) * 8; float t = 0.f;
#pragma unroll
            for (int k = 0; k < 8; ++k) t += __hip_atomic_load(slot + k, __ATOMIC_RELAXED, __HIP_MEMORY_SCOPE_AGENT);
            S[row] = 1.0f / sqrtf(t * (1.f / DM) + EPS); }
        asm volatile("s_waitcnt lgkmcnt(0)" ::: "memory"); __builtin_amdgcn_s_barrier(); asm volatile("" ::: "memory");
        const int c0 = u.pn * 256 + wc * 32 + 4 * fq;
#pragma unroll
        for (int bj = 0; bj < 2; ++bj)
#pragma unroll
            for (int n = 0; n < 2; ++n) { const f32x4 g = *(const f32x4*)(gain + c0 + bj * 128 + n * 16);
#pragma unroll
                for (int ai = 0; ai < 2; ++ai)
#pragma unroll
                    for (int m = 0; m < 4; ++m) { const int r = ai * 128 + wr * 64 + m * 16 + fr;
                        __builtin_nontemporal_store(acc[ai][bj][m][n] * S[r] * g, (f32x4*)(out + (size_t)(u.pm * 256 + r) * DM + c0 + bj * 128 + n * 16)); } }
    }
};
}

namespace att {
constexpr int D = 128, LD = DM, NW = 8, QBLK = 32, KVBLK = 64, QB = 256;
constexpr int SHM_V = KVBLK * D * 2, SHM_K = KVBLK * D * 2;
constexpr int NSLOT = 3, SLOT = SHM_V, OFF_K = NSLOT * SHM_V;
constexpr int OFF_WS = NSLOT * (SHM_V + SHM_K), OFF_C = OFF_WS + NW * 64 * 4, OFF_RED = OFF_C + KVROWS * 4, LDS_BYTES = OFF_RED + 64;
constexpr float THR2 = 11.5f;
#define KSWZ(row, colB) ((row) * 256 + ((colB) ^ (((row) & 7) << 4)))
#define SBAR() __builtin_amdgcn_sched_barrier(0)
__device__ __forceinline__ int v_st(int k, int c) { const int kk = (k & ~0xC) | ((k & 4) << 1) | ((k & 8) >> 1); return ((kk >> 3) * 4 + (c >> 5)) * 512 + ((kk & 7) * 32 + (c & 31)) * 2; }
__device__ __forceinline__ int v_rd_base(int lane) { return ((lane & 3) << 3) | (((lane >> 2) & 3) << 6) | (((lane >> 4) & 1) << 5) | (((lane >> 5) & 1) << 8); }
constexpr int v_rd_off(int d0, int ks, int half) { return d0 * 512 + ks * 4096 + half * 2048; }
__device__ __forceinline__ int crow(int r, int hi) { return (r & 3) + 8 * (r >> 2) + 4 * hi; }
__device__ __forceinline__ bf16x8 load8(const bf16_t* p) { return *reinterpret_cast<const bf16x8*>(p); }

__device__ __forceinline__ void mask_tile(f32x16& p0, f32x16& p1, int dq) {
    const float NEG = -__builtin_inff();
#pragma unroll
    for (int r = 0; r < 16; ++r) { const int c = (r & 3) + 8 * (r >> 2); if (dq - c < 0) p0[r] = NEG; if (dq - c - 32 < 0) p1[r] = NEG; }
}
__device__ __forceinline__ void mask_meta(f32x16& p0, f32x16& p1) {
    const float NEG = -__builtin_inff();
#pragma unroll
    for (int r = 0; r < 16; ++r) { p0[r] = NEG; if (r < 8) p1[r] = NEG; }
}
__device__ __forceinline__ void partialSM(f32x16& p0, f32x16& p1, float& m_reg, float& mn, float& alpha) {
    float pmax = p0[0];
#pragma unroll
    for (int r = 1; r < 16; ++r) pmax = fmaxf(pmax, p0[r]);
#pragma unroll
    for (int r = 0; r < 16; ++r) pmax = fmaxf(pmax, p1[r]);
    { auto rr = __builtin_amdgcn_permlane32_swap(__float_as_uint(pmax), __float_as_uint(pmax), false, false);
      pmax = fmaxf(__uint_as_float(rr[0]), __uint_as_float(rr[1])); }
    if (__builtin_expect(__all((pmax - m_reg) <= THR2), 1)) { mn = m_reg; alpha = 1.f; }
    else { mn = fmaxf(m_reg, pmax); alpha = __builtin_amdgcn_exp2f(m_reg - mn); m_reg = mn; }
#pragma unroll
    for (int r = 0; r < 16; ++r) p0[r] = p0[r] - mn;
#pragma unroll
    for (int r = 0; r < 16; ++r) p1[r] = p1[r] - mn;
#pragma unroll
    for (int r = 0; r < 16; ++r) p0[r] = __builtin_amdgcn_exp2f(p0[r]);
}
__device__ __forceinline__ void finishSM(f32x16& p0, f32x16& p1, float alpha, float& l_reg, bf16x8& pa0, bf16x8& pa1, bf16x8& pa2, bf16x8& pa3) {
#pragma unroll
    for (int r = 0; r < 16; ++r) p1[r] = __builtin_amdgcn_exp2f(p1[r]);
    float ps = 0;
#pragma unroll
    for (int r = 0; r < 16; ++r) ps += p0[r];
#pragma unroll
    for (int r = 0; r < 16; ++r) ps += p1[r];
    { auto rr = __builtin_amdgcn_permlane32_swap(__float_as_uint(ps), __float_as_uint(ps), false, false);
      ps = __uint_as_float(rr[0]) + __uint_as_float(rr[1]); }
    l_reg = l_reg * alpha + ps;
#define PK4(P, B_, OUT) do { unsigned a0 = cvt_pk_bf16(P[B_+0], P[B_+1]), a1 = cvt_pk_bf16(P[B_+2], P[B_+3]);                          \
        unsigned b0 = cvt_pk_bf16(P[B_+4], P[B_+5]), b1 = cvt_pk_bf16(P[B_+6], P[B_+7]);                                             \
        auto r0 = __builtin_amdgcn_permlane32_swap(a0, b0, false, false); auto r1 = __builtin_amdgcn_permlane32_swap(a1, b1, false, false); \
        u32x4 w = {r0[0], r1[0], r0[1], r1[1]}; OUT = *reinterpret_cast<bf16x8*>(&w); } while (0)
    PK4(p0, 0, pa0); PK4(p0, 8, pa1); PK4(p1, 0, pa2); PK4(p1, 8, pa3);
#undef PK4
}
__device__ __forceinline__ void qkt(f32x16& p0, f32x16& p1, const char* Kslot, int r32, int hi, const bf16x8* qr, const LAS f32x4* cp) {
#pragma unroll
    for (int g = 0; g < 4; ++g) { const f32x4 c0 = cp[2 * g], c1 = cp[8 + 2 * g];
#pragma unroll
        for (int j = 0; j < 4; ++j) { p0[4 * g + j] = c0[j]; p1[4 * g + j] = c1[j]; } }
    const char* kb[4];
#pragma unroll
    for (int dd = 0; dd < 4; ++dd) kb[dd] = Kslot + KSWZ(r32, (dd * 16 + hi * 8) * 2);
#pragma unroll
    for (int d0 = 0; d0 < 8; ++d0) { const char* a = kb[d0 & 3] + (d0 >> 2) * 128;
        bf16x8 b0 = *reinterpret_cast<const bf16x8*>(a);
        bf16x8 b1 = *reinterpret_cast<const bf16x8*>(a + 32 * 256);
        p0 = __builtin_amdgcn_mfma_f32_32x32x16_bf16(b0, qr[d0], p0, 0, 0, 0);
        p1 = __builtin_amdgcn_mfma_f32_32x32x16_bf16(b1, qr[d0], p1, 0, 0, 0); }
}
__device__ __forceinline__ void pv_tile(f32x16* o, int vb0, bf16x8 pa0, bf16x8 pa1, bf16x8 pa2, bf16x8 pa3) {
#define TRRD(dst, off) asm volatile("ds_read_b64_tr_b16 %0, %1 offset:%2" : "=&v"(dst) : "v"(vb0), "i"(off) : "memory")
#define PV_RD(d0, kh, X) do { constexpr int b_ = v_rd_off(d0, 2 * (kh), 0); TRRD(X##l0, b_); TRRD(X##h0, b_ + 2048); TRRD(X##l1, b_ + 4096); TRRD(X##h1, b_ + 6144); } while (0)
#define PV_MM(d0, X, PA, PB) do { \
        o[d0] = __builtin_amdgcn_mfma_f32_32x32x16_bf16(PA, (bf16x8){X##l0[0], X##l0[1], X##l0[2], X##l0[3], X##h0[0], X##h0[1], X##h0[2], X##h0[3]}, o[d0], 0, 0, 0);   \
        o[d0] = __builtin_amdgcn_mfma_f32_32x32x16_bf16(PB, (bf16x8){X##l1[0], X##l1[1], X##l1[2], X##l1[3], X##h1[0], X##h1[1], X##h1[2], X##h1[3]}, o[d0], 0, 0, 0); } while (0)
#define PV_W4() do { asm volatile("s_waitcnt lgkmcnt(4)" ::: "memory"); SBAR(); } while (0)
#define PV_W0() do { asm volatile("s_waitcnt lgkmcnt(0)" ::: "memory"); SBAR(); } while (0)
    s16x4 al0, al1, ah0, ah1, bl0, bl1, bh0, bh1;
    PV_RD(0, 0, a);
    PV_RD(0, 1, b); PV_W4(); PV_MM(0, a, pa0, pa1); SBAR();
    PV_RD(1, 0, a); PV_W4(); PV_MM(0, b, pa2, pa3); SBAR();
    PV_RD(1, 1, b); PV_W4(); PV_MM(1, a, pa0, pa1); SBAR();
    PV_RD(2, 0, a); PV_W4(); PV_MM(1, b, pa2, pa3); SBAR();
    PV_RD(2, 1, b); PV_W4(); PV_MM(2, a, pa0, pa1); SBAR();
    PV_RD(3, 0, a); PV_W4(); PV_MM(2, b, pa2, pa3); SBAR();
    PV_RD(3, 1, b); PV_W4(); PV_MM(3, a, pa0, pa1); SBAR();
    PV_W0(); PV_MM(3, b, pa2, pa3);
#undef PV_RD
#undef PV_MM
#undef PV_W4
#undef PV_W0
#undef TRRD
}

struct BlockRef { const bf16_t* Q; const bf16_t* K; const bf16_t* V; const bf16_t* Z; bf16_t* O; int P0; };
struct Seam { bf16x8 qr[8]; };
#define WAITV_BAR(N) asm volatile("s_waitcnt vmcnt(" #N ") lgkmcnt(0)\n\ts_barrier" ::: "memory")
struct DmaOff { unsigned k[2], v[2]; };
__device__ __forceinline__ DmaOff dma_offsets(int wid, int lane) {
    DmaOff d;
#pragma unroll
    for (int i = 0; i < 2; ++i) { const int pc = wid * 2 + i, q = pc * 64 + lane;
        const int row = q >> 4, j = (q & 15) ^ (row & 7); d.k[i] = (unsigned)(row * 256 + j * 16);
        const int s = q >> 5, w = q & 31, kk = (s >> 2) * 8 + (w >> 2), c = (s & 3) * 32 + (w & 3) * 8, k = (kk & ~0xC) | ((kk & 4) << 1) | ((kk & 8) >> 1);
        d.v[i] = (unsigned)(k * 256 + c * 2); }
    return d;
}
#define DMA_K(t, slot) do { _Pragma("unroll") for (int i_ = 0; i_ < 2; ++i_) __builtin_amdgcn_global_load_lds((const unsigned*)((const char*)Kh + (size_t)(t) * (KVBLK * D * 2) + dof.k[i_]), \
        (LAS unsigned*)((LAS unsigned char*)lds3 + OFF_K + (slot) + (wid * 2 + i_) * 1024), 16, 0, 0); } while (0)
#define DMA_V(t, slot) do { _Pragma("unroll") for (int i_ = 0; i_ < 2; ++i_) __builtin_amdgcn_global_load_lds((const unsigned*)((const char*)Vh + (size_t)(t) * (KVBLK * D * 2) + dof.v[i_]), \
        (LAS unsigned*)((LAS unsigned char*)lds3 + (slot) + (wid * 2 + i_) * 1024), 16, 0, 0); } while (0)
__device__ __forceinline__ void fox_prime(const BlockRef& cur, char* lds, Seam& S, const int tid) {
    const int wid = __builtin_amdgcn_readfirstlane(tid >> 6), lane = tid & 63, r32 = lane & 31, hi = lane >> 5;
    LAS unsigned char* lds3 = (LAS unsigned char*)lds; const DmaOff dof = dma_offsets(wid, lane);
    const bf16_t* Kh = cur.K; const bf16_t* Vh = cur.V;
#pragma unroll
    for (int d0 = 0; d0 < 8; ++d0) S.qr[d0] = load8(cur.Q + (size_t)(wid * QBLK + r32) * LD + d0 * 16 + hi * 8);
    SBAR(); DMA_K(0, 0); DMA_K(1, SLOT); DMA_V(0, 0); SBAR();
    WAITV_BAR(0);
}
__device__ __forceinline__ void fox_block(const BlockRef& cur, const BlockRef& nxt, char* lds, Seam& S, const int tid) {
    const int wid = __builtin_amdgcn_readfirstlane(tid >> 6), lane = tid & 63, r32 = lane & 31, hi = lane >> 5;
    const int NT = cur.P0 / KVBLK + 4;
    const int qlo = cur.P0 + wid * QBLK, qm = qlo + r32 - 4 * hi;
    char* V_lds = lds; char* K_lds = lds + OFF_K; LAS unsigned char* lds3 = (LAS unsigned char*)lds;
    float* ws = (float*)(lds + OFF_WS) + wid * 64; float* li_l = ws, * al_l = ws + 32;
    const LAS float* ctab = (const LAS float*)(LAS char*)(lds + OFF_C);
    float m_reg = -1e30f, l_reg = 0; f32x16 o[4] = {};
    const DmaOff dof = dma_offsets(wid, lane);
    const int vb0 = (int)(uintptr_t)V_lds + v_rd_base(lane);
    const bf16_t* Kh = cur.K; const bf16_t* Vh = cur.V;
#define RESC(a) do { if (__any((a) < 1.f)) { if (hi == 0) al_l[r32] = (a); asm volatile("s_waitcnt lgkmcnt(0)" ::: "memory");              \
                     for (int d_ = 0; d_ < 4; ++d_) for (int r = 0; r < 16; ++r) o[d_][r] *= al_l[crow(r, hi)]; } } while (0)
#define MASKT(P0_, P1_, t) do { const int kb_ = (t) * KVBLK; if (kb_ + KVBLK - 1 > qlo) mask_tile(P0_, P1_, qm - kb_); } while (0)
#define CTP(t) ((const LAS f32x4*)(ctab + (t) * KVBLK + 4 * hi))
#define ROT() do { s_prev = s_cur; s_cur = s_next; s_next = s_nn; s_nn = (s_nn == (NSLOT - 1) * SLOT) ? 0 : s_nn + SLOT; } while (0)
#define ENDW(t) do { if ((t) + 2 < NT) { WAITV_BAR(4); } else if ((t) + 1 < NT) { WAITV_BAR(2); } else { WAITV_BAR(0); } } while (0)
    f32x16 pA0, pA1, pB0, pB1; float mnA, mnB, alA, alB; bf16x8 pa0, pa1, pa2, pa3;
    int s_prev = 0, s_cur = 0, s_next = SLOT, s_nn = 2 * SLOT;
    SBAR(); DMA_K(2, s_nn); DMA_V(1, s_next); SBAR();
    qkt(pA0, pA1, K_lds + s_cur, r32, hi, S.qr, CTP(0));
    mask_meta(pA0, pA1); partialSM(pA0, pA1, m_reg, mnA, alA);
    SBAR(); WAITV_BAR(4);
    ROT();
#define STEP(PX0, PX1, mnX, alX, PY0, PY1, alY, t) do {                                                                       \
        SBAR(); if ((t) + 2 < NT) { DMA_K((t) + 2, s_nn); } if ((t) + 1 < NT) { DMA_V((t) + 1, s_next); }                     \
        SBAR(); qkt(PX0, PX1, K_lds + s_cur, r32, hi, S.qr, CTP(t));                                                          \
        finishSM(PY0, PY1, alY, l_reg, pa0, pa1, pa2, pa3); SBAR();                                                           \
        pv_tile(o, vb0 + s_prev, pa0, pa1, pa2, pa3); MASKT(PX0, PX1, (t)); partialSM(PX0, PX1, m_reg, mnX, alX);             \
        RESC(alX);                                                                                                            \
        SBAR(); ENDW(t);                                                                                                      \
        ROT(); } while (0)
    for (int t = 1; t + 1 < NT; t += 2) {
        STEP(pB0, pB1, mnB, alB, pA0, pA1, alA, t);
        STEP(pA0, pA1, mnA, alA, pB0, pB1, alB, t + 1);
    }
    finishSM(pA0, pA1, alA, l_reg, pa0, pa1, pa2, pa3); SBAR();
    pv_tile(o, vb0 + s_prev, pa0, pa1, pa2, pa3);
    SBAR(); WAITV_BAR(0);
    { const bf16_t* Kh = nxt.K; const bf16_t* Vh = nxt.V;
#pragma unroll
      for (int d0 = 0; d0 < 8; ++d0) S.qr[d0] = load8(nxt.Q + (size_t)(wid * QBLK + r32) * LD + d0 * 16 + hi * 8);
      SBAR(); DMA_K(0, 0); DMA_K(1, SLOT); DMA_V(0, 0); SBAR(); }
    if (hi == 0) li_l[r32] = l_reg; asm volatile("s_waitcnt lgkmcnt(0)" ::: "memory");
    float rli[16];
#pragma unroll
    for (int r = 0; r < 16; ++r) rli[r] = __builtin_amdgcn_rcpf(li_l[crow(r, hi)]);
    typedef __attribute__((address_space(1))) bf16_t gbf16; typedef __attribute__((address_space(1))) u32x4 gu32x4;
    LAS float* stg = (LAS float*)(lds3 + SLOT + wid * 4096);
    const int er = lane >> 2, eq = lane & 3;
    gbf16* obase = (gbf16*)(cur.O + (size_t)(wid * QBLK + er) * LD + 8 * eq); const gbf16* zbase = (const gbf16*)(cur.Z + (size_t)(wid * QBLK + er) * LD + 8 * eq);
#pragma unroll
    for (int d0 = 0; d0 < 4; ++d0) {
#pragma unroll
        for (int r = 0; r < 16; ++r) stg[crow(r, hi) * 32 + r32] = o[d0][r] * rli[r];
        asm volatile("s_waitcnt lgkmcnt(0)" ::: "memory");
        gbf16* op = obase; const gbf16* zp = zbase;
#pragma unroll
        for (int i = 0; i < 2; ++i) {
            asm volatile("" : "+v"(op), "+v"(zp));
            const f32x4 v0 = *(const LAS f32x4*)(stg + (er + 16 * i) * 32 + 8 * eq), v1 = *(const LAS f32x4*)(stg + (er + 16 * i) * 32 + 8 * eq + 4);
            const u32x4 z = __builtin_nontemporal_load((const gu32x4*)(zp + d0 * 32));
            u32x4 w; w.x = cvt_pk_bf16(v0.x * bf_lo(z.x), v0.y * bf_hi(z.x)); w.y = cvt_pk_bf16(v0.z * bf_lo(z.y), v0.w * bf_hi(z.y));
            w.z = cvt_pk_bf16(v1.x * bf_lo(z.z), v1.y * bf_hi(z.z)); w.w = cvt_pk_bf16(v1.z * bf_lo(z.w), v1.w * bf_hi(z.w));
            *(gu32x4*)(op + d0 * 32) = w;
            op += 16 * LD; zp += 16 * LD; }
        asm volatile("s_waitcnt lgkmcnt(0)" ::: "memory"); }
    WAITV_BAR(0);
#undef RESC
#undef MASKT
#undef CTP
#undef ROT
#undef ENDW
#undef STEP
}
#undef DMA_K
#undef DMA_V
#undef WAITV_BAR
#undef ROWP
#undef VMW
#undef VMWN
#undef SLOAD_H
#undef SWRITE_H
__device__ __forceinline__ void build_ctab(char* lds, const float* LFbh, const int tid) {
    const int lane = tid & 63, wid = tid >> 6;
    float* ctab = (float*)(lds + OFF_C); float* red = (float*)(lds + OFF_RED);
    constexpr int PER = 9; const int e0 = tid * PER;
    float v[PER]; float s = 0.f;
#pragma unroll
    for (int i = 0; i < PER; ++i) { const int kk = e0 + i; float x = 0.f; if (kk >= 48 && kk < KVROWS) x = LFbh[kk]; s += x; v[i] = s; }
    float incl = s;
#pragma unroll
    for (int off = 1; off < 64; off <<= 1) { const float t = __shfl_up(incl, off); if (lane >= off) incl += t; }
    if (lane == 63) red[wid] = incl;
    __syncthreads();
    float base = incl - s;
    for (int w = 0; w < wid; ++w) base += red[w];
#pragma unroll
    for (int i = 0; i < PER; ++i) { const int kk = e0 + i; if (kk < KVROWS) ctab[kk] = -(base + v[i]); }
    __syncthreads();
}
struct Tensors { const bf16_t* Q; const bf16_t* K; const bf16_t* V; const bf16_t* Z; bf16_t* O; const float* LF; };
__device__ __forceinline__ BlockRef mkref(const Tensors& T, int b, int h, int qb) {
    BlockRef r; const size_t qo = (size_t)(b * SEQ + qb * QB) * LD + h * D, ko = (size_t)(b * NH + h) * KVROWS * D;
    r.Q = T.Q + qo; r.Z = T.Z + qo; r.O = T.O + qo; r.K = T.K + ko; r.V = T.V + ko; r.P0 = 64 + qb * QB; return r;
}
__device__ __forceinline__ void attn_phase(char* lds, const Tensors& T, int vcu, int G) {
    for (int L = vcu; L < NB * NH * 8; L += G) {
        const int bh = L >> 3, x = L & 7, b = bh >> 4, h = bh & 15;
        int tid = threadIdx.x; asm volatile("" : "+v"(tid));
        build_ctab(lds, T.LF + (size_t)(b * NH + h) * KVROWS, tid);
        const BlockRef r0 = mkref(T, b, h, 15 - x), r1 = mkref(T, b, h, x);
        Seam S;
        fox_prime(r0, lds, S, tid);
        fox_block(r0, r1, lds, S, tid);
        fox_block(r1, r1, lds, S, tid);
    }
}
#undef SBAR
#undef KSWZ
}

constexpr int NWAVES = 8, NTHREADS = 512;
constexpr int LDS_BYTES = 147456;
static_assert(att::LDS_BYTES <= 131072 && pg8::STAGE_BYTES <= 131072, "LDS map");

struct Args { const float* in[10]; float* out; unsigned char* ws; int ph_lo, ph_hi; };

__device__ __forceinline__ unsigned f2bf(float f) { unsigned u = __builtin_bit_cast(unsigned, f); return (u + 0x7fffu + ((u >> 16) & 1u)) >> 16; }
__device__ __forceinline__ unsigned pk2(float lo, float hi) { return cvt_pk_bf16(lo, hi); }
__device__ __forceinline__ float wave_sum(float v) {
#pragma unroll
    for (int o = 1; o < 64; o <<= 1) v += __shfl_xor(v, o);
    return v;
}
__device__ __forceinline__ int src_col_of_dst(int r0) {
    if (r0 < 6144) return r0;
    if (r0 < 8192) return r0 + 16;
    if (r0 < 12288) { const int p = (r0 - 8192) >> 8, w = (r0 - 8192) & 255; return (w < 128 ? 8208 : 12304) + 128 * p + (w & 127); }
    if (r0 < 16384) { const int p = (r0 - 12288) >> 8, w = (r0 - 12288) & 255; return (w < 128 ? 10256 : 14352) + 128 * p + (w & 127); }
    if (r0 < 20480) { const int p = (r0 - 16384) >> 8, w = (r0 - 16384) & 255; return (w < 128 ? 16400 : 18448) + 128 * p + (w & 127); }
    return 6144;
}
struct TrItem { const float* src; bf16_t* dst; int ldn, nvalid4; };
__device__ __forceinline__ void tr_load(f32x4 (&v)[16], const TrItem& t, int lane) {
    const int ks = lane >> 4, g = lane & 15;
#pragma unroll
    for (int i = 0; i < 16; ++i) v[i] = (g < t.nvalid4) ? __builtin_nontemporal_load((const f32x4*)(t.src + (size_t)(4 * i + ks) * t.ldn + 4 * g)) : (f32x4){0.f, 0.f, 0.f, 0.f};
}
__device__ __forceinline__ void tr_process(const f32x4 (&v)[16], const TrItem& t, LAS float* scr, int lane) {
    const int ks = lane >> 4, g = lane & 15;
#pragma unroll
    for (int i = 0; i < 16; ++i) { LAS float* w = scr + (4 * i + ks) * 65 + 4 * g; w[0] = v[i].x; w[1] = v[i].y; w[2] = v[i].z; w[3] = v[i].w; }
    asm volatile("s_waitcnt lgkmcnt(0)" ::: "memory");
    const int c = lane & 7;
#pragma unroll
    for (int j = 0; j < 8; ++j) { const int n = (lane >> 3) + 8 * j; const LAS float* s = scr + (8 * c) * 65 + n;
        u32x4 o; o.x = pk2(s[0 * 65], s[1 * 65]); o.y = pk2(s[2 * 65], s[3 * 65]); o.z = pk2(s[4 * 65], s[5 * 65]); o.w = pk2(s[6 * 65], s[7 * 65]);
        if (n < 4 * t.nvalid4 || t.nvalid4 == 16) *(u32x4*)(t.dst + (size_t)n * 2048 + 8 * c) = o; }
    asm volatile("s_waitcnt lgkmcnt(0)" ::: "memory");
}
__device__ __forceinline__ void rms_rows2_to_bf16(const float* xa, bf16_t* oa, const float* xb, bf16_t* ob, bool hasb, const float* gain, int lane) {
    const f32x4* ra = (const f32x4*)xa + lane; const f32x4* rb = (const f32x4*)(hasb ? xb : xa) + lane; const f32x4* gr = (const f32x4*)gain + lane;
    f32x4 v[8], w[8]; float s = 0.f, s2 = 0.f;
#pragma unroll
    for (int j = 0; j < 8; ++j) v[j] = __builtin_nontemporal_load(ra + 64 * j);
#pragma unroll
    for (int j = 0; j < 8; ++j) w[j] = __builtin_nontemporal_load(rb + 64 * j);
#pragma unroll
    for (int j = 0; j < 8; ++j) { s += (v[j].x * v[j].x + v[j].y * v[j].y) + (v[j].z * v[j].z + v[j].w * v[j].w); s2 += (w[j].x * w[j].x + w[j].y * w[j].y) + (w[j].z * w[j].z + w[j].w * w[j].w); }
    const float rstd = 1.0f / sqrtf(wave_sum(s) * (1.f / DM) + EPS), rstd2 = 1.0f / sqrtf(wave_sum(s2) * (1.f / DM) + EPS);
    unsigned long long* o8 = (unsigned long long*)oa + lane; unsigned long long* p8 = (unsigned long long*)ob + lane;
#pragma unroll
    for (int j = 0; j < 8; ++j) { const f32x4 g = gr[64 * j]; const f32x4 y = v[j] * rstd * g, z = w[j] * rstd2 * g;
        o8[64 * j] = (unsigned long long)pk2(y.x, y.y) | ((unsigned long long)pk2(y.z, y.w) << 32);
        if (hasb) p8[64 * j] = (unsigned long long)pk2(z.x, z.y) | ((unsigned long long)pk2(z.z, z.w) << 32); }
}
__device__ __forceinline__ void zero_bytes16(void* p, size_t nbytes, int gt, int ngt) {
    u32x4* q = (u32x4*)p; const size_t n = nbytes / 16;
    for (size_t i = gt; i < n; i += ngt) q[i] = (u32x4){0u, 0u, 0u, 0u};
}

__device__ __forceinline__ void p1_side_task(int c, LAS unsigned char* lds, const bf16_t* XN, const bf16_t* WIN, const float* b_f, float* LF, bf16_t* Kb, bf16_t* Vb, bf16_t* P1b) {
    const int tid = threadIdx.x, lane = tid & 63, w = __builtin_amdgcn_readfirstlane(tid >> 6), fr = lane & 15, fq = lane >> 4;
    const bf16_t* XM = XN + (size_t)MREAL * DM;
    const bf16_t* WF = WIN + (size_t)20480 * DM;
    int n0, n1;
    if (c < 64) { n0 = 2048 + 32 * c; n1 = n0 + 16; } else if (c < 128) { n0 = 4096 + 32 * (c - 64); n1 = n0 + 16; }
    else { const int ch0 = 16 * (c - 128); n0 = 8192 + 256 * (ch0 >> 7) + (ch0 & 127); n1 = n0 + 128; }
    const size_t lo_ = (size_t)fr * DM + 256 * w + 8 * fq;
    const bf16_t* P6[6] = {XN + (size_t)(32 * c) * DM + lo_, XN + (size_t)(32 * c + 16) * DM + lo_, XM + lo_, WF + lo_, WIN + (size_t)n0 * DM + lo_, WIN + (size_t)n1 * DM + lo_};
    bf16x8 fr6[6][8];
#pragma unroll
    for (int s = 0; s < 6; ++s)
#pragma unroll
        for (int i = 0; i < 8; ++i) fr6[s][i] = *(const bf16x8*)(P6[s] + 32 * i);
    f32x4 acc[5];
#pragma unroll
    for (int g = 0; g < 5; ++g) acc[g] = (f32x4){0.f, 0.f, 0.f, 0.f};
#pragma unroll
    for (int i = 0; i < 8; ++i) {
        acc[0] = __builtin_amdgcn_mfma_f32_16x16x32_bf16(fr6[0][i], fr6[3][i], acc[0], 0, 0, 0);
        acc[1] = __builtin_amdgcn_mfma_f32_16x16x32_bf16(fr6[1][i], fr6[3][i], acc[1], 0, 0, 0);
        acc[2] = __builtin_amdgcn_mfma_f32_16x16x32_bf16(fr6[2][i], fr6[3][i], acc[2], 0, 0, 0);
        acc[3] = __builtin_amdgcn_mfma_f32_16x16x32_bf16(fr6[4][i], fr6[2][i], acc[3], 0, 0, 0);
        acc[4] = __builtin_amdgcn_mfma_f32_16x16x32_bf16(fr6[5][i], fr6[2][i], acc[4], 0, 0, 0);
    }
    LAS f32x4* red = (LAS f32x4*)lds;
#pragma unroll
    for (int g = 0; g < 5; ++g) red[(w * 5 + g) * 64 + lane] = acc[g];
    __syncthreads();
    if (w == 0) {
#pragma unroll
        for (int g = 0; g < 5; ++g) { f32x4 s = red[g * 64 + lane];
#pragma unroll
            for (int ww = 1; ww < 8; ++ww) s += red[(ww * 5 + g) * 64 + lane];
            acc[g] = s; }
        const float bfh = b_f[fr];
#pragma unroll
        for (int g = 0; g < 3; ++g)
#pragma unroll
            for (int j = 0; j < 4; ++j) { const float xx = acc[g][j] + bfh; const float v = (fminf(xx, 0.f) - log1pf(__expf(-fabsf(xx)))) * LOG2E; const int m = 4 * fq + j;
                if (g < 2) { const int row = 32 * c + 16 * g + m; LF[(size_t)((row >> 12) * NH + fr) * KVROWS + 64 + (row & 4095)] = v; }
                else if (c == 0) { LF[(size_t)fr * KVROWS + 48 + m] = v; LF[(size_t)(NH + fr) * KVROWS + 48 + m] = v; } }
        if (c < 128) {
            bf16_t* T = (c < 64) ? Kb : Vb; const int col0 = (c < 64) ? 32 * c : 32 * (c - 64);
#pragma unroll
            for (int g = 0; g < 2; ++g)
#pragma unroll
                for (int j = 0; j < 4; ++j) { const bf16_t v = (bf16_t)(cvt_pk_bf16(acc[3 + g][j], 0.f) & 0xffffu); const int col = col0 + 16 * g + 4 * fq + j;
                    const size_t o_ = ((size_t)(col >> 7) * KVROWS + 48 + fr) * HD + (col & 127); T[o_] = v; T[o_ + (size_t)NH * KVROWS * HD] = v; }
        } else if (fr >= 14) {
            const int ch0 = 16 * (c - 128);
#pragma unroll
            for (int j = 0; j < 4; ++j) { const bf16_t v = (bf16_t)(cvt_pk_bf16(acc[3][j] * acc[4][j], 0.f) & 0xffffu); const int col = ch0 + 4 * fq + j;
                P1b[(size_t)(fr - 14) * DM + col] = v; P1b[(size_t)(P1ROWS + fr - 14) * DM + col] = v; }
        }
    }
    __syncthreads();
}

#define XB_TMO      128
#define XB_XCNT(j)  (256  + 64 * (j))
#define XB_XSUB(j)  (1280 + 64 * (j))
#define XB_XGEN(j)  (2304 + 64 * (j))
#define XB_TOP      3328
#define XB_TOPGEN   3392
#define XCD_BAR_WORDS 3456
#define XB_SPIN_CAP (1u << 22)
__device__ __forceinline__ unsigned xb_ld(unsigned* p)              { return __hip_atomic_load(p, __ATOMIC_RELAXED, __HIP_MEMORY_SCOPE_AGENT); }
__device__ __forceinline__ unsigned xb_add(unsigned* p, unsigned v) { return __hip_atomic_fetch_add(p, v, __ATOMIC_RELAXED, __HIP_MEMORY_SCOPE_AGENT); }
__device__ __forceinline__ unsigned xb_xcc_id() { return (unsigned)__builtin_amdgcn_s_getreg((3 << 11) | 20) & 0xFu; }
#define XB_SPIN(cond, bar) do { unsigned _sp = 0; while (cond) { __builtin_amdgcn_s_sleep(1); \
    if ((++_sp & 255u) == 0u) { if (xb_ld(&(bar)[XB_TMO])) break; if (_sp > XB_SPIN_CAP) { atomicAdd(&(bar)[XB_TMO], 1u); break; } } } } while (0)
struct XcdBarrier { unsigned* bar; unsigned x; volatile LAS unsigned* st; };
__device__ __forceinline__ XcdBarrier xcd_barrier_post(unsigned* bar, volatile LAS unsigned* st) {
    XcdBarrier b; b.bar = bar; b.x = xb_xcc_id(); b.st = st;
    if (threadIdx.x == 0) (void)xb_add(&bar[XB_XCNT(b.x)], 1u);
    return b;
}
__device__ __forceinline__ void xcd_barrier_complete(unsigned* bar, unsigned x, unsigned& nloc, unsigned& nx) {
    const unsigned G = gridDim.x * gridDim.y * gridDim.z;
    unsigned sum, cnt, mine, sp = 0u;
    for (;;) {
        sum = 0u; cnt = 0u; mine = 0u;
#pragma unroll
        for (unsigned j = 0; j < 16; ++j) { const unsigned c = xb_ld(&bar[XB_XCNT(j)]); sum += c; cnt += (c > 0u) ? 1u : 0u; mine = (j == x) ? c : mine; }
        if (sum == G) break;
        __builtin_amdgcn_s_sleep(1);
        if ((++sp & 255u) == 0u) { if (xb_ld(&bar[XB_TMO])) break; if (sp > XB_SPIN_CAP) { atomicAdd(&bar[XB_TMO], 1u); break; } }
    }
    nloc = mine > 0u ? mine : 1u; nx = cnt > 0u ? cnt : 1u;
}
__device__ __forceinline__ void xcd_barrier(const XcdBarrier& b) {
    asm volatile("s_waitcnt vmcnt(0)" ::: "memory");
    __syncthreads();
    if (threadIdx.x == 0) {
        unsigned* bar = b.bar;
        __builtin_amdgcn_s_waitcnt(0);
        unsigned nloc = b.st[0], nx = b.st[1];
        if (nloc == 0u) { xcd_barrier_complete(bar, b.x, nloc, nx); b.st[0] = nloc; b.st[1] = nx; }
        const unsigned old = xb_add(&bar[XB_XSUB(b.x)], 1u);
        const unsigned gen = old / nloc;
        if (old + 1u == (gen + 1u) * nloc) {
            __builtin_amdgcn_fence(__ATOMIC_RELEASE, "agent");
            asm volatile("s_waitcnt vmcnt(0)" ::: "memory");
            const unsigned og = xb_add(&bar[XB_TOP], 1u);
            const unsigned tg = og / nx;
            if (og + 1u == (tg + 1u) * nx) xb_add(&bar[XB_TOPGEN], 1u);
            else XB_SPIN(xb_ld(&bar[XB_TOPGEN]) == tg, bar);
            __builtin_amdgcn_fence(__ATOMIC_ACQUIRE, "agent");
            xb_add(&bar[XB_XGEN(b.x)], 1u);
            asm volatile("s_waitcnt vmcnt(0)" ::: "memory");
        } else {
            XB_SPIN(xb_ld(&bar[XB_XGEN(b.x)]) == gen, bar);
            __builtin_amdgcn_fence(__ATOMIC_ACQUIRE, "agent");
            asm volatile("s_waitcnt vmcnt(0)" ::: "memory");
        }
    }
    __syncthreads();
}

__device__ __forceinline__ void grid_barrier(unsigned* ctr, unsigned target) {
    asm volatile("s_waitcnt vmcnt(0)" ::: "memory");
    __syncthreads();
    if (threadIdx.x == 0) {
        __builtin_amdgcn_fence(__ATOMIC_RELEASE, "agent");
        asm volatile("s_waitcnt vmcnt(0)" ::: "memory");
        __hip_atomic_fetch_add(ctr, 1u, __ATOMIC_RELAXED, __HIP_MEMORY_SCOPE_AGENT);
        while (__hip_atomic_load(ctr, __ATOMIC_RELAXED, __HIP_MEMORY_SCOPE_AGENT) < target) __builtin_amdgcn_s_sleep(2);
        __builtin_amdgcn_fence(__ATOMIC_ACQUIRE, "agent");
        asm volatile("s_waitcnt vmcnt(0)" ::: "memory");
    }
    __syncthreads();
}

__global__ void __launch_bounds__(NTHREADS, 2) fox_fwd(Args args) {
    extern __shared__ __attribute__((aligned(16))) unsigned char lds[];
    if (args.ph_lo < 0) cg::this_grid().sync();
#define tid ((int)threadIdx.x)
#define lane (tid & 63)
    const int wave = __builtin_amdgcn_readfirstlane(tid >> 6);
    const int G = gridDim.x, bx = blockIdx.x, vcu = (G % 8 == 0) ? (bx % 8) * (G / 8) + bx / 8 : bx;
    unsigned char* ws = args.ws;
    const float* x = args.in[0]; const float* meta = args.in[1]; const float* norm_gain = args.in[2]; const float* w_in = args.in[3];
    const float* b_f = args.in[4]; const float* conv_w = args.in[5]; const float* w_att_o = args.in[6]; const float* w_conv_o = args.in[7];
    const float* w_out = args.in[8]; const float* final_gain = args.in[9];
    bf16_t* WIN = (bf16_t*)(ws + WS_WIN); bf16_t* WATT = (bf16_t*)(ws + WS_WATT); bf16_t* WCONV = (bf16_t*)(ws + WS_WCONV); bf16_t* WOUT = (bf16_t*)(ws + WS_WOUT);
    bf16_t* XN = (bf16_t*)(ws + WS_XN); bf16_t* Qb = (bf16_t*)(ws + WS_Q); bf16_t* Kb = (bf16_t*)(ws + WS_K); bf16_t* Vb = (bf16_t*)(ws + WS_V);
    bf16_t* Zb = (bf16_t*)(ws + WS_Z); bf16_t* P1b = (bf16_t*)(ws + WS_P1); bf16_t* P2b = (bf16_t*)(ws + WS_P2); bf16_t* Rb = (bf16_t*)(ws + WS_R);
    bf16_t* S2b = (bf16_t*)(ws + WS_S2); bf16_t* AATT = (bf16_t*)(ws + WS_AATT); bf16_t* ACONV = (bf16_t*)(ws + WS_ACONV); bf16_t* MG = (bf16_t*)(ws + WS_MG);
    float* LF = (float*)(ws + WS_LF); float* SS = (float*)(ws + WS_SS);
    const int lo = args.ph_lo, hi = args.ph_hi;
    volatile LAS unsigned* xst = (volatile LAS unsigned*)((LAS unsigned char*)lds + LDS_BYTES - 64);
    if (tid < 16) xst[tid] = 0u;
    __syncthreads();
    XcdBarrier xbar; xbar.bar = (unsigned*)(ws + WS_CTL) + 8192; xbar.x = 0; xbar.st = xst;
    if (hi - lo > 1) xbar = xcd_barrier_post((unsigned*)(ws + WS_CTL) + 8192, xst);
#define IN(k) (lo <= (k) && (k) < hi)
#define SEAM(k) do { if (IN(k) && IN((k) + 1)) { xcd_barrier(xbar); } } while (0)
#define REP(k) for (int rep_ = 0; rep_ < ((PROBE_REPEAT == (k)) ? 2 : 1); ++rep_)
#define REPBAR(k) do { if (PROBE_REPEAT == (k) && rep_ == 0) grid_barrier((unsigned*)(ws + WS_CTL) + 64 * (8 + (k)), (unsigned)G); } while (0)
    const int gw = vcu * NWAVES + wave, NGW = G * NWAVES, ngt = G * NTHREADS;
#define gt (bx * NTHREADS + tid)

    if (IN(0)) REP(0) {
        LAS float* scr = (LAS float*)((LAS unsigned char*)lds + wave * 16640);
        constexpr int NG_IN = 321, I_IN = NG_IN * 32, I_SQ = 32 * 32, NITEMS = I_IN + 3 * I_SQ;
#define TR_DECODE(T_, it_) do { int r_ = (it_); if (r_ < I_IN) { const bool tail_ = r_ >= 320 * 32; const int kb = tail_ ? (r_ - 320 * 32) : (((r_ >> 2) & 1) | (((r_ >> 3) & 15) << 1)), grp = tail_ ? 320 : ((r_ & 3) | ((r_ >> 7) << 2)); T_.src = w_in + (size_t)(kb * 64) * N_IN + src_col_of_dst(grp * 64); T_.dst = WIN + (size_t)(grp * 64) * 2048 + kb * 64; T_.ldn = N_IN; T_.nvalid4 = (grp == 320) ? 4 : 16; } \
            else { r_ -= I_IN; const int which = r_ / I_SQ; r_ -= which * I_SQ; const int kb = ((r_ >> 2) & 1) | (((r_ >> 3) & 15) << 1), grp = (r_ & 3) | ((r_ >> 7) << 2); T_.src = (which == 0 ? w_att_o : which == 1 ? w_conv_o : w_out) + (size_t)(kb * 64) * DM + grp * 64; \
                   T_.dst = (which == 0 ? WATT : which == 1 ? WCONV : WOUT) + (size_t)(grp * 64) * 2048 + kb * 64; T_.ldn = DM; T_.nvalid4 = 16; } } while (0)
        {
            f32x4 va[16], vb[16]; TrItem ta, tb; int it = gw;
            if (it < NITEMS) { TR_DECODE(ta, it); tr_load(va, ta, lane); }
            while (it < NITEMS) {
                int it2 = it + NGW; if (it2 < NITEMS) { TR_DECODE(tb, it2); tr_load(vb, tb, lane); }
                tr_process(va, ta, scr, lane);
                it = it2; if (it >= NITEMS) break;
                it2 = it + NGW; if (it2 < NITEMS) { TR_DECODE(ta, it2); tr_load(va, ta, lane); }
                tr_process(vb, tb, scr, lane);
                it = it2;
            }
        }
#undef TR_DECODE
        for (int m = gw; m < MREAL + NMETA; m += 2 * NGW) { const int m2 = m + NGW;
            rms_rows2_to_bf16(m < MREAL ? x + (size_t)m * DM : meta + (size_t)(m - MREAL) * DM, XN + (size_t)m * DM,
                              m2 < MREAL ? x + (size_t)m2 * DM : meta + (size_t)(m2 - MREAL) * DM, XN + (size_t)m2 * DM, m2 < MREAL + NMETA, norm_gain, lane); }
        for (int bh = 0; bh < NB * NH; ++bh) { zero_bytes16(Kb + (size_t)bh * KVROWS * HD, (size_t)48 * HD * 2, gt, ngt); zero_bytes16(Vb + (size_t)bh * KVROWS * HD, (size_t)48 * HD * 2, gt, ngt); }
        REPBAR(0);
    }
    SEAM(0);
    if (IN(1)) REP(1) {
        pg8::Gemm g{XN, WIN, nullptr, nullptr, MREAL, 20480, DM}; pg8::StaticOrder<1> S; S.init(MREAL, 20480, G, bx);
        pg8::EpiProj E{Qb, Kb, Vb, Zb, P1b, P2b, Rb, S2b};
        pg8::gemm_phase<pg8::EpiProj, pg8::StaticOrder<1>, 1>((LAS unsigned char*)lds, g, S, E);
        for (int srep = 0; srep < SIDE_REPS; ++srep) for (int c = bx; c < 256; c += G) p1_side_task(c, (LAS unsigned char*)lds, XN, WIN, b_f, LF, Kb, Vb, P1b);
        REPBAR(1);
    }
    SEAM(1);
    if (IN(2)) REP(2) {
        const att::Tensors T{Qb, Kb, Vb, Zb, AATT, LF};
        att::attn_phase((char*)lds, T, vcu, G);
        for (int idx = gt; idx < MREAL * 256; idx += ngt) {
            const int row = idx >> 8, ch = (idx & 255) * 8, b = row >> 12; const size_t pr = (size_t)(row + 2 * b) * DM + ch;
            const u32x4 a0 = *(const u32x4*)(P1b + pr), a1 = *(const u32x4*)(P1b + pr + DM), a2 = *(const u32x4*)(P1b + pr + 2 * DM), gg = *(const u32x4*)(P2b + (size_t)row * DM + ch);
            const f32x4 w0a = *(const f32x4*)(conv_w + ch), w0b = *(const f32x4*)(conv_w + ch + 4), w1a = *(const f32x4*)(conv_w + DM + ch), w1b = *(const f32x4*)(conv_w + DM + ch + 4),
                        w2a = *(const f32x4*)(conv_w + 2 * DM + ch), w2b = *(const f32x4*)(conv_w + 2 * DM + ch + 4);
            u32x4 o;
#define CONV2(W, A0, A1, A2, GW, wa, wb, wc_, j0) W = cvt_pk_bf16(bf_lo(GW) * (wa[j0] * bf_lo(A0) + wb[j0] * bf_lo(A1) + wc_[j0] * bf_lo(A2)), bf_hi(GW) * (wa[j0 + 1] * bf_hi(A0) + wb[j0 + 1] * bf_hi(A1) + wc_[j0 + 1] * bf_hi(A2)))
            CONV2(o.x, a0.x, a1.x, a2.x, gg.x, w0a, w1a, w2a, 0); CONV2(o.y, a0.y, a1.y, a2.y, gg.y, w0a, w1a, w2a, 2);
            CONV2(o.z, a0.z, a1.z, a2.z, gg.z, w0b, w1b, w2b, 0); CONV2(o.w, a0.w, a1.w, a2.w, gg.w, w0b, w1b, w2b, 2);
#undef CONV2
            *(u32x4*)(ACONV + (size_t)row * DM + ch) = o;
        }
        REPBAR(2);
    }
    SEAM(2);
    if (IN(3)) REP(3) {
        pg8::Gemm g{AATT, WATT, ACONV, WCONV, MREAL, DM, DM}; pg8::StaticOrder<2> S; S.init(MREAL, DM, G, bx);
        pg8::EpiMerge E{Rb, S2b, MG};
        pg8::gemm_phase<pg8::EpiMerge, pg8::StaticOrder<2>, 2>((LAS unsigned char*)lds, g, S, E);
        REPBAR(3);
    }
    SEAM(3);
    const bool fused_norm = (G == 256) && IN(4) && IN(5);
    if (IN(4)) {
        pg8::Gemm g{MG, WOUT, nullptr, nullptr, MREAL, DM, DM}; pg8::StaticOrder<1> S; S.init(MREAL, DM, G, bx);
        if (fused_norm) { pg8::EpiOutNorm E{x, args.out, final_gain, SS, (unsigned*)(ws + WS_CTL) + 2048};
            pg8::gemm_phase<pg8::EpiOutNorm, pg8::StaticOrder<1>, 1, false, true>((LAS unsigned char*)lds, g, S, E); }
        else { pg8::EpiOut E{x, args.out, SS};
            pg8::gemm_phase<pg8::EpiOut, pg8::StaticOrder<1>, 1>((LAS unsigned char*)lds, g, S, E); }
    }
    if (!fused_norm) {
    SEAM(4);
    if (IN(5)) {
        for (int m = gw; m < MREAL; m += NGW) {
            float s = (lane < 32) ? SS[(size_t)m * 32 + lane] : 0.f; s = wave_sum(s);
            const float rstd = 1.0f / sqrtf(s * (1.f / DM) + EPS);
            f32x4* o = (f32x4*)(args.out + (size_t)m * DM) + lane; const f32x4* gr = (const f32x4*)final_gain + lane;
#pragma unroll
            for (int j = 0; j < 8; ++j) { const f32x4 y = o[64 * j]; o[64 * j] = y * rstd * gr[64 * j]; }
        }
    }
    }
#undef IN
#undef SEAM
#undef REP
#undef REPBAR
#undef tid
#undef lane
#undef gt
}

extern "C" void kernel_launch(void* const* d_in, const int* in_sizes, int n_in, void* d_out, int out_size, void* d_ws, size_t ws_size, hipStream_t stream) {
    static int grid = 0;
    if (grid == 0) {
        if (n_in != 10 || in_sizes[0] != MREAL * DM || out_size != MREAL * DM || ws_size < WS_END) {
            fprintf(stderr, "kernel_launch: unexpected shapes (n_in %d, in0 %d, out %d, ws %zu < %zu?)\n", n_in, n_in > 0 ? in_sizes[0] : -1, out_size, ws_size, (size_t)WS_END); grid = -1; return; }
        int dev = 0, cus = 0, per_cu = 0;
        (void)hipGetDevice(&dev); (void)hipDeviceGetAttribute(&cus, hipDeviceAttributeMultiprocessorCount, dev);
        if (hipFuncSetAttribute((const void*)fox_fwd, hipFuncAttributeMaxDynamicSharedMemorySize, LDS_BYTES) != hipSuccess) { fprintf(stderr, "kernel_launch: hipFuncSetAttribute failed\n"); grid = -1; return; }
        if (hipOccupancyMaxActiveBlocksPerMultiprocessor(&per_cu, (const void*)fox_fwd, NTHREADS, LDS_BYTES) != hipSuccess || per_cu < 1) { fprintf(stderr, "kernel_launch: occupancy query says %d\n", per_cu); per_cu = 1; }
        (void)hipGetLastError();
        if (cus <= 0) cus = 256;
        grid = cus;
    }
    if (grid < 0) return;
    Args a{};
    for (int i = 0; i < 10; ++i) a.in[i] = (const float*)d_in[i];
    a.out = (float*)d_out; a.ws = (unsigned char*)d_ws;
#if MK_COOP
    a.ph_lo = 0; a.ph_hi = 6;
    (void)hipMemsetAsync((unsigned char*)d_ws + WS_CTL, 0, 65536, stream);
    void* kargs[] = {&a};
    hipError_t e = hipLaunchCooperativeKernel((const void*)fox_fwd, dim3(grid), dim3(NTHREADS), kargs, LDS_BYTES, stream);
    if (e != hipSuccess) fprintf(stderr, "kernel_launch: cooperative launch failed: %s (grid %d)\n", hipGetErrorString(e), grid);
#else
    for (int p = 0; p < 6; ++p) { a.ph_lo = p; a.ph_hi = p + 1; hipLaunchKernelGGL(fox_fwd, dim3(grid), dim3(NTHREADS), LDS_BYTES, stream, a); }
#endif
}
```

```cpp
#include <hip/hip_runtime.h>
#include <hip/hip_cooperative_groups.h>
#include <cstdio>
#include <cstdint>
namespace cg = cooperative_groups;

#ifndef PROBE_REPEAT
#define PROBE_REPEAT -1
#endif
#ifndef SIDE_REPS
#define SIDE_REPS 1
#endif
#ifndef MK_COOP
#define MK_COOP 1
#endif

#define LAS __attribute__((address_space(3)))
typedef unsigned short bf16_t;
typedef short bf16x8 __attribute__((ext_vector_type(8)));
typedef short s16x4 __attribute__((ext_vector_type(4)));
typedef float f32x4 __attribute__((ext_vector_type(4)));
typedef float f32x2 __attribute__((ext_vector_type(2)));
typedef float f32x16 __attribute__((ext_vector_type(16)));
typedef unsigned u32x4 __attribute__((ext_vector_type(4)));
typedef unsigned u32x2 __attribute__((ext_vector_type(2)));

constexpr int DM = 2048, NB = 2, SEQ = 4096, NMETA = 16, NH = 16, HD = 128;
constexpr int MREAL = NB * SEQ;
constexpr int MALL = MREAL + 256;
constexpr int N_IN = 20496;
constexpr int NPROJ = 81 * 256;
constexpr int KVROWS = 64 + SEQ;
constexpr int P1ROWS = 2 + SEQ;
constexpr float EPS = 1e-6f;
constexpr float LOG2E = 1.4426950408889634f;
constexpr float QSCALE = 0.08838834764831845f * 1.4426950408889634f;

constexpr size_t MiB = 1u << 20;
constexpr size_t WS_WIN = 0, WS_WATT = 81 * MiB, WS_WCONV = 89 * MiB, WS_WOUT = 97 * MiB, WS_XN = 105 * MiB, WS_Q = 138 * MiB,
                 WS_K = 170 * MiB, WS_V = 203 * MiB, WS_Z = 236 * MiB, WS_P1 = 268 * MiB, WS_P2 = 301 * MiB, WS_R = 333 * MiB,
                 WS_S2 = 365 * MiB, WS_AATT = 397 * MiB, WS_ACONV = 429 * MiB, WS_MG = 461 * MiB, WS_LF = 493 * MiB, WS_SS = 494 * MiB,
                 WS_CTL = 495 * MiB, WS_END = 496 * MiB;

__device__ __forceinline__ unsigned cvt_pk_bf16(float lo, float hi) { unsigned r; asm volatile("v_cvt_pk_bf16_f32 %0, %1, %2" : "=v"(r) : "v"(lo), "v"(hi)); return r; }
__device__ __forceinline__ float bf_lo(unsigned w) { return __uint_as_float(w << 16); }
__device__ __forceinline__ float bf_hi(unsigned w) { return __uint_as_float(w & 0xffff0000u); }
__device__ __forceinline__ float sigmoidf_(float x) { return __builtin_amdgcn_rcpf(1.0f + __expf(-x)); }
__device__ __forceinline__ float siluf_(float x) { return x * sigmoidf_(x); }

namespace pg8 {
constexpr int BM = 256, BK = 64, HALF = 128, HTB = HALF * BK * 2, STAGE_BYTES = 8 * HTB, NXCD = 8, WGM = 8;
__host__ __device__ __forceinline__ int lds_byte(int r, int c) { const int st = (r >> 4) * 2 + (c >> 5), rr = r & 15, cc = c & 31, ob = rr * 64 + cc * 2; return st * 1024 + (ob ^ (((ob >> 9) & 1) << 5)); }
__host__ __device__ __forceinline__ void stage_rc(int b, int& R, int& C) { const int st = b / 1024, sb = b % 1024, swz = sb ^ (((sb >> 9) & 1) << 5); R = (st >> 1) * 16 + swz / 64; C = (st & 1) * 32 + (swz % 64) / 2; }
__host__ __device__ __forceinline__ int perm32(int rho) { const int n = rho >> 4, i = rho & 15; return 8 * (i >> 2) + 4 * n + (i & 3); }

struct Unit { int pm, pn, seg; };
struct Gemm { const bf16_t* A; const bf16_t* Bt; const bf16_t* A2; const bf16_t* Bt2; int M, N, K; };

template <int NSEG> struct StaticOrder {
    int nM, nN, nwg, G, c;
    __device__ void init(int M, int N, int G_, int c_) { nM = M / BM; nN = N / BM; nwg = nM * nN; G = G_; c = c_; }
    __device__ bool next(int i, Unit& u) const {
        const int ti = (NSEG == 2) ? (i >> 1) : i; u.seg = (NSEG == 2) ? (i & 1) : 0;
        const long L = (long)ti * G + c; if (L >= nwg) return false;
        int wgid = (int)L; { const int q = nwg / NXCD, r = nwg % NXCD, xcd = wgid % NXCD, off = wgid / NXCD; wgid = (xcd < r ? xcd * (q + 1) : r * (q + 1) + (xcd - r) * q) + off; }
        const int nig = WGM * nN, gid = wgid / nig, fm = gid * WGM, gsz = (nM - fm) < WGM ? (nM - fm) : WGM;
        u.pm = fm + ((wgid % nig) % gsz); u.pn = (wgid % nig) / gsz; return true;
    }
};

typedef f32x4 Acc[2][2][4][2];

template <class Epi, class Sched, int NSEG, bool ALIGN_EPI = true, bool AFTER_DRAIN = false>
__device__ __forceinline__ void gemm_phase(LAS unsigned char* lds, const Gemm g, const Sched& S, const Epi& E) {
    const int tid = threadIdx.x, wid = __builtin_amdgcn_readfirstlane(tid >> 6), lane = tid & 63, wr = wid >> 2, wc = wid & 3, fr = lane & 15, fq = lane >> 4;
    const int K = g.K, nt = K / BK;
    unsigned voffA[2], voffB[2];
#pragma unroll
    for (int i = 0; i < 2; ++i) { int R, C; stage_rc(tid * 16 + i * 8192, R, C); const int Rb = Epi::PERM ? ((R & ~31) + perm32(R & 31)) : R;
        voffA[i] = (unsigned)(R * K + C) * 2u; voffB[i] = (unsigned)(Rb * K + C) * 2u; }
    const size_t kstep = (size_t)(BK * 2);
    const size_t hstep = (size_t)HALF * K * 2;
    const size_t tstep = 2 * hstep;
    const unsigned ldsw = (unsigned)wid * 1024u;
    const int aoff = lds_byte(wr * 64 + fr, fq * 8), boff = lds_byte(wc * 32 + fr, fq * 8);
#define PG8_SA(b, h) (((b) * 2 + (h)) * HTB)
#define PG8_SB(b, h) ((4 + (b) * 2 + (h)) * HTB)
#define PG8_STAGE(bufoff, gbase, voff) do { _Pragma("unroll") for (int _i = 0; _i < 2; ++_i) \
        __builtin_amdgcn_global_load_lds((const unsigned*)((const char*)(gbase) + (voff)[_i]), (LAS unsigned*)(lds + (bufoff) + ldsw + _i * 8192), 16, 0, 0); } while (0)
#define PG8_LDA(dst, b, h) do { _Pragma("unroll") for (int m = 0; m < 4; ++m) _Pragma("unroll") for (int k = 0; k < 2; ++k) dst[m][k] = *(const LAS bf16x8*)(lds + PG8_SA(b, h) + aoff + m * 2048 + k * 1024); } while (0)
#define PG8_LDB(dst, b, h) do { _Pragma("unroll") for (int n = 0; n < 2; ++n) _Pragma("unroll") for (int k = 0; k < 2; ++k) dst[n][k] = *(const LAS bf16x8*)(lds + PG8_SB(b, h) + boff + n * 2048 + k * 1024); } while (0)
#define PG8_MMA(ai, bj, At, Bt) do { __builtin_amdgcn_s_setprio(1); _Pragma("unroll") for (int m = 0; m < 4; ++m) _Pragma("unroll") for (int n = 0; n < 2; ++n) _Pragma("unroll") for (int k = 0; k < 2; ++k) \
        acc[ai][bj][m][n] = __builtin_amdgcn_mfma_f32_16x16x32_bf16(Bt[n][k], At[m][k], acc[ai][bj][m][n], 0, 0, 0); __builtin_amdgcn_s_setprio(0); } while (0)
#define PG8_WAIT_V(n) asm volatile("s_waitcnt vmcnt(" #n ")" ::: "memory")
#define PG8_WAIT_L(n) asm volatile("s_waitcnt lgkmcnt(" #n ")" ::: "memory")
#define PG8_BAR __builtin_amdgcn_s_barrier()
#define PG8_SCHED __builtin_amdgcn_sched_barrier(0)
#define PG8_ABASE(u) ((const char*)(((NSEG == 2) && (u).seg) ? g.A2 : g.A) + (size_t)(u).pm * tstep)
#define PG8_BBASE(u) ((const char*)(((NSEG == 2) && (u).seg) ? g.Bt2 : g.Bt) + (size_t)(u).pn * tstep)
    Unit cur, nxt; int ui = 0;
    if (!S.next(0, cur)) return;
    f32x4 acc[2][2][4][2];
#pragma unroll
    for (int a = 0; a < 2; ++a)
#pragma unroll
        for (int b = 0; b < 2; ++b)
#pragma unroll
            for (int m = 0; m < 4; ++m)
#pragma unroll
                for (int n = 0; n < 2; ++n) acc[a][b][m][n] = (f32x4){0.f, 0.f, 0.f, 0.f};
    bf16x8 At[4][2], B0[2][2], B1[2][2];
    const char* cA = PG8_ABASE(cur); const char* cB = PG8_BBASE(cur);
    PG8_STAGE(PG8_SB(0, 0), cB, voffB); PG8_STAGE(PG8_SB(0, 1), cB + hstep, voffB); PG8_STAGE(PG8_SA(0, 0), cA, voffA); PG8_STAGE(PG8_SA(0, 1), cA + hstep, voffA);
    if (wr == 1) PG8_BAR;
    PG8_WAIT_V(2); PG8_BAR;
    PG8_STAGE(PG8_SB(1, 0), cB + kstep, voffB); PG8_STAGE(PG8_SA(1, 0), cA + kstep, voffA); PG8_STAGE(PG8_SB(1, 1), cB + hstep + kstep, voffB);
    PG8_WAIT_V(6); PG8_BAR;
    for (;;) {
        const bool has_next = S.next(ui + 1, nxt);
        const char* nA = has_next ? PG8_ABASE(nxt) : cA; const char* nB = has_next ? PG8_BBASE(nxt) : cB;
        for (int t = 0; t < nt; t += 2) {
            const bool last = (t == nt - 2);
            const char* a1 = cA + (size_t)(t + 1) * kstep;
            const char* a2 = last ? nA : cA + (size_t)(t + 2) * kstep; const char* b2 = last ? nB : cB + (size_t)(t + 2) * kstep;
            const char* a3 = a2 + kstep; const char* b3 = b2 + kstep;
            PG8_LDB(B0, 0, 0); PG8_LDB(B1, 0, 1); PG8_SCHED; PG8_LDA(At, 0, 0); PG8_STAGE(PG8_SA(1, 1), a1 + hstep, voffA);
            PG8_WAIT_V(8); PG8_WAIT_L(0); PG8_BAR; PG8_MMA(0, 0, At, B0); PG8_MMA(0, 1, At, B1); PG8_BAR; PG8_SCHED;
            PG8_LDA(At, 0, 1); PG8_STAGE(PG8_SB(0, 0), b2, voffB); PG8_STAGE(PG8_SB(0, 1), b2 + hstep, voffB); PG8_STAGE(PG8_SA(0, 0), a2, voffA);
            PG8_WAIT_V(8); PG8_WAIT_L(0); PG8_BAR; PG8_MMA(1, 0, At, B0); PG8_MMA(1, 1, At, B1); PG8_BAR; PG8_SCHED;
            PG8_LDB(B0, 1, 0); PG8_LDB(B1, 1, 1); PG8_SCHED; PG8_LDA(At, 1, 0); PG8_STAGE(PG8_SA(0, 1), a2 + hstep, voffA);
            PG8_WAIT_V(8); PG8_WAIT_L(0); PG8_BAR; PG8_MMA(0, 0, At, B0); PG8_MMA(0, 1, At, B1); PG8_BAR; PG8_SCHED;
            PG8_LDA(At, 1, 1); PG8_STAGE(PG8_SB(1, 0), b3, voffB); PG8_STAGE(PG8_SB(1, 1), b3 + hstep, voffB); PG8_STAGE(PG8_SA(1, 0), a3, voffA);
            PG8_WAIT_V(8); PG8_WAIT_L(0); PG8_BAR; PG8_MMA(1, 0, At, B0); PG8_MMA(1, 1, At, B1); PG8_BAR; PG8_SCHED;
        }
        if constexpr (ALIGN_EPI) { if (wr == 0) PG8_BAR; }
        const bool midseg = (NSEG == 2) && (cur.seg == 0);
        if (midseg) E.mid(acc, cur, wr, wc, fr, fq); else if constexpr (!AFTER_DRAIN) E(acc, cur, wr, wc, fr, fq);
        if (!has_next) break;
        if (!midseg) {
#pragma unroll
            for (int a = 0; a < 2; ++a)
#pragma unroll
                for (int b = 0; b < 2; ++b)
#pragma unroll
                    for (int m = 0; m < 4; ++m)
#pragma unroll
                        for (int n = 0; n < 2; ++n) acc[a][b][m][n] = (f32x4){0.f, 0.f, 0.f, 0.f};
        }
        cur = nxt; cA = nA; cB = nB; ++ui;
        if constexpr (ALIGN_EPI) { if (wr == 1) PG8_BAR; }
    }
    PG8_WAIT_V(0);
    if constexpr (!ALIGN_EPI) { if (wr == 0) PG8_BAR; }
    PG8_BAR;
    if constexpr (AFTER_DRAIN) E.fused(acc, cur, wr, wc, fr, fq, lds, wid, lane);
#undef PG8_SA
#undef PG8_SB
#undef PG8_STAGE
#undef PG8_LDA
#undef PG8_LDB
#undef PG8_MMA
#undef PG8_WAIT_V
#undef PG8_WAIT_L
#undef PG8_BAR
#undef PG8_SCHED
#undef PG8_ABASE
#undef PG8_BBASE
}

__device__ __forceinline__ u32x4 pack8(f32x4 v0, f32x4 v1) { u32x4 w; w.x = cvt_pk_bf16(v0[0], v0[1]); w.y = cvt_pk_bf16(v0[2], v0[3]); w.z = cvt_pk_bf16(v1[0], v1[1]); w.w = cvt_pk_bf16(v1[2], v1[3]); return w; }

struct EpiProj {
    static constexpr bool PERM = true;
    bf16_t *Q, *K, *V, *Z, *P1, *P2, *R, *S2;
    __device__ __forceinline__ void mid(Acc&, const Unit&, int, int, int, int) const {}
    __device__ __forceinline__ void operator()(const Acc& acc, const Unit& u, int wr, int wc, int fr, int fq) const {
        const int pm = u.pm, pn = u.pn; const int b = pm >> 4;
        const int rloc = wr * 64 + fr, cl = wc * 32 + 8 * fq;
        if (pn < 32) {
            const int kind = pn >> 3, colt = (pn & 7) * 256 + cl;
            if (kind == 0 || kind == 3) {
                bf16_t* base = (kind == 0 ? Q : Z) + (size_t)(pm * 256 + rloc) * DM + colt;
#pragma unroll
                for (int ai = 0; ai < 2; ++ai)
#pragma unroll
                    for (int m = 0; m < 4; ++m)
#pragma unroll
                        for (int bj = 0; bj < 2; ++bj) { f32x4 v0 = acc[ai][bj][m][0], v1 = acc[ai][bj][m][1];
                            if (kind == 0) { v0 = v0 * QSCALE; v1 = v1 * QSCALE; }
                            else {
#pragma unroll
                                for (int j = 0; j < 4; ++j) { v0[j] = siluf_(v0[j]); v1[j] = siluf_(v1[j]); } }
                            *(u32x4*)(base + (size_t)(ai * 128 + m * 16) * DM + bj * 128) = pack8(v0, v1); }
            } else {
                bf16_t* base = (kind == 1 ? K : V) + ((size_t)(b * NH + 2 * (pn & 7)) * KVROWS + 64 + (pm & 15) * 256 + rloc) * HD + cl;
#pragma unroll
                for (int ai = 0; ai < 2; ++ai)
#pragma unroll
                    for (int m = 0; m < 4; ++m)
#pragma unroll
                        for (int bj = 0; bj < 2; ++bj) *(u32x4*)(base + (size_t)bj * KVROWS * HD + (size_t)(ai * 128 + m * 16) * HD) = pack8(acc[ai][bj][m][0], acc[ai][bj][m][1]);
            }
        } else {
            const int kind = (pn - 32) >> 4, p = (pn - 32) & 15, col = p * 128 + cl;
            if (kind == 0) {
                bf16_t* base = P1 + (size_t)(pm * 256 + 2 + 2 * b + rloc) * DM + col;
#pragma unroll
                for (int ai = 0; ai < 2; ++ai)
#pragma unroll
                    for (int m = 0; m < 4; ++m) __builtin_nontemporal_store(pack8(acc[ai][0][m][0] * acc[ai][1][m][0], acc[ai][0][m][1] * acc[ai][1][m][1]), (u32x4*)(base + (size_t)(ai * 128 + m * 16) * DM));
            } else if (kind == 1) {
                bf16_t* base = P2 + (size_t)(pm * 256 + rloc) * DM + col;
#pragma unroll
                for (int ai = 0; ai < 2; ++ai)
#pragma unroll
                    for (int m = 0; m < 4; ++m) { f32x4 v0, v1;
#pragma unroll
                        for (int j = 0; j < 4; ++j) { v0[j] = acc[ai][0][m][0][j] * siluf_(acc[ai][1][m][0][j]); v1[j] = acc[ai][0][m][1][j] * siluf_(acc[ai][1][m][1][j]); }
                        __builtin_nontemporal_store(pack8(v0, v1), (u32x4*)(base + (size_t)(ai * 128 + m * 16) * DM)); }
            } else {
                const size_t o0 = (size_t)(pm * 256 + rloc) * DM + col;
#pragma unroll
                for (int ai = 0; ai < 2; ++ai)
#pragma unroll
                    for (int m = 0; m < 4; ++m) { f32x4 r0, r1, s0, s1;
#pragma unroll
                        for (int j = 0; j < 4; ++j) { const float e1a = 1.0f + __expf(-acc[ai][0][m][0][j]), e2a = 1.0f + __expf(-acc[ai][1][m][0][j]);
                            const float e1b = 1.0f + __expf(-acc[ai][0][m][1][j]), e2b = 1.0f + __expf(-acc[ai][1][m][1][j]);
                            s0[j] = __builtin_amdgcn_rcpf(e2a); s1[j] = __builtin_amdgcn_rcpf(e2b); r0[j] = e2a * __builtin_amdgcn_rcpf(e1a); r1[j] = e2b * __builtin_amdgcn_rcpf(e1b); }
                        const size_t o = o0 + (size_t)(ai * 128 + m * 16) * DM;
                        __builtin_nontemporal_store(pack8(r0, r1), (u32x4*)(R + o)); __builtin_nontemporal_store(pack8(s0, s1), (u32x4*)(S2 + o)); }
            }
        }
    }
};

struct EpiMerge {
    static constexpr bool PERM = true;
    const bf16_t *R, *S2; bf16_t* MG;
    __device__ __forceinline__ void mid(Acc& acc, const Unit& u, int wr, int wc, int fr, int fq) const {
        const bf16_t* base = R + (size_t)(u.pm * 256 + wr * 64 + fr) * DM + u.pn * 256 + wc * 32 + 8 * fq;
#pragma unroll
        for (int ai = 0; ai < 2; ++ai)
#pragma unroll
            for (int m = 0; m < 4; ++m)
#pragma unroll
                for (int bj = 0; bj < 2; ++bj) { const u32x4 w = __builtin_nontemporal_load((const u32x4*)(base + (size_t)(ai * 128 + m * 16) * DM + bj * 128));
                    acc[ai][bj][m][0] *= (f32x4){bf_lo(w.x), bf_hi(w.x), bf_lo(w.y), bf_hi(w.y)}; acc[ai][bj][m][1] *= (f32x4){bf_lo(w.z), bf_hi(w.z), bf_lo(w.w), bf_hi(w.w)}; }
    }
    __device__ __forceinline__ void operator()(const Acc& acc, const Unit& u, int wr, int wc, int fr, int fq) const {
        const size_t o0 = (size_t)(u.pm * 256 + wr * 64 + fr) * DM + u.pn * 256 + wc * 32 + 8 * fq;
#pragma unroll
        for (int ai = 0; ai < 2; ++ai)
#pragma unroll
            for (int m = 0; m < 4; ++m)
#pragma unroll
                for (int bj = 0; bj < 2; ++bj) { const size_t o = o0 + (size_t)(ai * 128 + m * 16) * DM + bj * 128; const u32x4 w = __builtin_nontemporal_load((const u32x4*)(S2 + o));
                    const f32x4 v0 = acc[ai][bj][m][0] * (f32x4){bf_lo(w.x), bf_hi(w.x), bf_lo(w.y), bf_hi(w.y)}, v1 = acc[ai][bj][m][1] * (f32x4){bf_lo(w.z), bf_hi(w.z), bf_lo(w.w), bf_hi(w.w)};
                    *(u32x4*)(MG + o) = pack8(v0, v1); }
    }
};

struct EpiOut {
    static constexpr bool PERM = false;
    const float* x; float* out; float* SS;
    __device__ __forceinline__ void mid(Acc&, const Unit&, int, int, int, int) const {}
    __device__ __forceinline__ void operator()(const Acc& acc, const Unit& u, int wr, int wc, int fr, int fq) const {
        const size_t o0 = (size_t)(u.pm * 256 + wr * 64 + fr) * DM + u.pn * 256 + wc * 32 + 4 * fq;
#pragma unroll
        for (int ai = 0; ai < 2; ++ai)
#pragma unroll
            for (int m = 0; m < 4; ++m) { float s = 0.f; const size_t o = o0 + (size_t)(ai * 128 + m * 16) * DM;
#pragma unroll
                for (int bj = 0; bj < 2; ++bj)
#pragma unroll
                    for (int n = 0; n < 2; ++n) { const f32x4 y = *(const f32x4*)(x + o + bj * 128 + n * 16) + acc[ai][bj][m][n];
                        s += (y[0] * y[0] + y[1] * y[1]) + (y[2] * y[2] + y[3] * y[3]); *(f32x4*)(out + o + bj * 128 + n * 16) = y; }
                s += __shfl_xor(s, 16); s += __shfl_xor(s, 32);
                if (fq == 0) SS[(size_t)(u.pm * 256 + wr * 64 + fr + ai * 128 + m * 16) * 32 + u.pn * 4 + wc] = s; }
    }
};
struct EpiOutNorm {
    static constexpr bool PERM = false;
    const float* x; float* out; const float* gain; float* xbuf; unsigned* cnt;
    __device__ __forceinline__ void mid(Acc&, const Unit&, int, int, int, int) const {}
    __device__ __forceinline__ void operator()(const Acc&, const Unit&, int, int, int, int) const {}
    __device__ __forceinline__ void fused(Acc& acc, const Unit& u, int wr, int wc, int fr, int fq, LAS unsigned char* lds, int wid, int lane) const {
        LAS float* P = (LAS float*)lds;
        LAS float* S = (LAS float*)(lds + 8192);
        const size_t o0 = (size_t)(u.pm * 256 + wr * 64 + fr) * DM + u.pn * 256 + wc * 32 + 4 * fq;
#pragma unroll
        for (int ai = 0; ai < 2; ++ai)
#pragma unroll
            for (int m = 0; m < 4; ++m) { float s = 0.f; const size_t o = o0 + (size_t)(ai * 128 + m * 16) * DM;
#pragma unroll
                for (int bj = 0; bj < 2; ++bj)
#pragma unroll
                    for (int n = 0; n < 2; ++n) { const f32x4 y = __builtin_nontemporal_load((const f32x4*)(x + o + bj * 128 + n * 16)) + acc[ai][bj][m][n]; acc[ai][bj][m][n] = y;
                        s += (y[0] * y[0] + y[1] * y[1]) + (y[2] * y[2] + y[3] * y[3]); }
                s += __shfl_xor(s, 16); s += __shfl_xor(s, 32);
                if (fq == 0) P[(ai * 128 + wr * 64 + m * 16 + fr) * 4 + wc] = s; }
        asm volatile("s_waitcnt lgkmcnt(0)" ::: "memory"); __builtin_amdgcn_s_barrier(); asm volatile("" ::: "memory");
        const int row = wid * 32 + (lane & 31);
        if (lane < 32) { const float t = (P[row * 4 + 0] + P[row * 4 + 1]) + (P[row * 4 + 2] + P[row * 4 + 3]);
            __hip_atomic_store(xbuf + (size_t)(u.pm * 256 + row) * 8 + u.pn, t, __ATOMIC_RELAXED, __HIP_MEMORY_SCOPE_AGENT); }
        asm volatile("s_waitcnt vmcnt(0)" ::: "memory");
        if (lane == 0) __hip_atomic_fetch_add(cnt + 64 * u.pm, 1u, __ATOMIC_RELAXED, __HIP_MEMORY_SCOPE_AGENT);
        if (wid == 0) {
            while ((unsigned)__builtin_amdgcn_readfirstlane(__hip_atomic_load(cnt + 64 * u.pm, __ATOMIC_RELAXED, __HIP_MEMORY_SCOPE_AGENT)) < 64u) __builtin_amdgcn_s_sleep(2);
            __builtin_amdgcn_fence(__ATOMIC_ACQUIRE, "agent");
        }
        asm volatile("s_waitcnt vmcnt(0) lgkmcnt(0)" ::: "memory"); __builtin_amdgcn_s_barrier(); asm volatile("" ::: "memory");
        if (lane < 32) { const float* slot = xbuf + (size_t)(u.pm * 256 + row) * 8; float t = 0.f;
#pragma unroll
            for (int k = 0; k < 8; ++k) t += __hip_atomic_load(slot + k, __ATOMIC_RELAXED, __HIP_MEMORY_SCOPE_AGENT);
            S[row] = 1.0f / sqrtf(t * (1.f / DM) + EPS); }
        asm volatile("s_waitcnt lgkmcnt(0)" ::: "memory"); __builtin_amdgcn_s_barrier(); asm volatile("" ::: "memory");
        const int c0 = u.pn * 256 + wc * 32 + 4 * fq;
#pragma unroll
        for (int bj = 0; bj < 2; ++bj)
#pragma unroll
            for (int n = 0; n < 2; ++n) { const f32x4 g = *(const f32x4*)(gain + c0 + bj * 128 + n * 16);
#pragma unroll
                for (int ai = 0; ai < 2; ++ai)
#pragma unroll
                    for (int m = 0; m < 4; ++m) { const int r = ai * 128 + wr * 64 + m * 16 + fr;
                        __builtin_nontemporal_store(acc[ai][bj][m][n] * S[r] * g, (f32x4*)(out + (size_t)(u.pm * 256 + r) * DM + c0 + bj * 128 + n * 16)); } }
    }
};
}

namespace att {
constexpr int D = 128, LD = DM, NW = 8, QBLK = 32, KVBLK = 64, QB = 256;
constexpr int SHM_V = KVBLK * D * 2, SHM_K = KVBLK * D * 2;
constexpr int NSLOT = 3, SLOT = SHM_V, OFF_K = NSLOT * SHM_V;
constexpr int OFF_WS = NSLOT * (SHM_V + SHM_K), OFF_C = OFF_WS + NW * 64 * 4, OFF_RED = OFF_C + KVROWS * 4, LDS_BYTES = OFF_RED + 64;
constexpr float THR2 = 11.5f;
#define KSWZ(row, colB) ((row) * 256 + ((colB) ^ (((row) & 7) << 4)))
#define SBAR() __builtin_amdgcn_sched_barrier(0)
__device__ __forceinline__ int v_st(int k, int c) { const int kk = (k & ~0xC) | ((k & 4) << 1) | ((k & 8) >> 1); return ((kk >> 3) * 4 + (c >> 5)) * 512 + ((kk & 7) * 32 + (c & 31)) * 2; }
__device__ __forceinline__ int v_rd_base(int lane) { return ((lane & 3) << 3) | (((lane >> 2) & 3) << 6) | (((lane >> 4) & 1) << 5) | (((lane >> 5) & 1) << 8); }
constexpr int v_rd_off(int d0, int ks, int half) { return d0 * 512 + ks * 4096 + half * 2048; }
__device__ __forceinline__ int crow(int r, int hi) { return (r & 3) + 8 * (r >> 2) + 4 * hi; }
__device__ __forceinline__ bf16x8 load8(const bf16_t* p) { return *reinterpret_cast<const bf16x8*>(p); }

__device__ __forceinline__ void mask_tile(f32x16& p0, f32x16& p1, int dq) {
    const float NEG = -__builtin_inff();
#pragma unroll
    for (int r = 0; r < 16; ++r) { const int c = (r & 3) + 8 * (r >> 2); if (dq - c < 0) p0[r] = NEG; if (dq - c - 32 < 0) p1[r] = NEG; }
}
__device__ __forceinline__ void mask_meta(f32x16& p0, f32x16& p1) {
    const float NEG = -__builtin_inff();
#pragma unroll
    for (int r = 0; r < 16; ++r) { p0[r] = NEG; if (r < 8) p1[r] = NEG; }
}
__device__ __forceinline__ void partialSM(f32x16& p0, f32x16& p1, float& m_reg, float& mn, float& alpha) {
    float pmax = p0[0];
#pragma unroll
    for (int r = 1; r < 16; ++r) pmax = fmaxf(pmax, p0[r]);
#pragma unroll
    for (int r = 0; r < 16; ++r) pmax = fmaxf(pmax, p1[r]);
    { auto rr = __builtin_amdgcn_permlane32_swap(__float_as_uint(pmax), __float_as_uint(pmax), false, false);
      pmax = fmaxf(__uint_as_float(rr[0]), __uint_as_float(rr[1])); }
    if (__builtin_expect(__all((pmax - m_reg) <= THR2), 1)) { mn = m_reg; alpha = 1.f; }
    else { mn = fmaxf(m_reg, pmax); alpha = __builtin_amdgcn_exp2f(m_reg - mn); m_reg = mn; }
#pragma unroll
    for (int r = 0; r < 16; ++r) p0[r] = p0[r] - mn;
#pragma unroll
    for (int r = 0; r < 16; ++r) p1[r] = p1[r] - mn;
#pragma unroll
    for (int r = 0; r < 16; ++r) p0[r] = __builtin_amdgcn_exp2f(p0[r]);
}
__device__ __forceinline__ void finishSM(f32x16& p0, f32x16& p1, float alpha, float& l_reg, bf16x8& pa0, bf16x8& pa1, bf16x8& pa2, bf16x8& pa3) {
#pragma unroll
    for (int r = 0; r < 16; ++r) p1[r] = __builtin_amdgcn_exp2f(p1[r]);
    float ps = 0;
#pragma unroll
    for (int r = 0; r < 16; ++r) ps += p0[r];
#pragma unroll
    for (int r = 0; r < 16; ++r) ps += p1[r];
    { auto rr = __builtin_amdgcn_permlane32_swap(__float_as_uint(ps), __float_as_uint(ps), false, false);
      ps = __uint_as_float(rr[0]) + __uint_as_float(rr[1]); }
    l_reg = l_reg * alpha + ps;
#define PK4(P, B_, OUT) do { unsigned a0 = cvt_pk_bf16(P[B_+0], P[B_+1]), a1 = cvt_pk_bf16(P[B_+2], P[B_+3]);                          \
        unsigned b0 = cvt_pk_bf16(P[B_+4], P[B_+5]), b1 = cvt_pk_bf16(P[B_+6], P[B_+7]);                                             \
        auto r0 = __builtin_amdgcn_permlane32_swap(a0, b0, false, false); auto r1 = __builtin_amdgcn_permlane32_swap(a1, b1, false, false); \
        u32x4 w = {r0[0], r1[0], r0[1], r1[1]}; OUT = *reinterpret_cast<bf16x8*>(&w); } while (0)
    PK4(p0, 0, pa0); PK4(p0, 8, pa1); PK4(p1, 0, pa2); PK4(p1, 8, pa3);
#undef PK4
}
__device__ __forceinline__ void qkt(f32x16& p0, f32x16& p1, const char* Kslot, int r32, int hi, const bf16x8* qr, const LAS f32x4* cp) {
#pragma unroll
    for (int g = 0; g < 4; ++g) { const f32x4 c0 = cp[2 * g], c1 = cp[8 + 2 * g];
#pragma unroll
        for (int j = 0; j < 4; ++j) { p0[4 * g + j] = c0[j]; p1[4 * g + j] = c1[j]; } }
    const char* kb[4];
#pragma unroll
    for (int dd = 0; dd < 4; ++dd) kb[dd] = Kslot + KSWZ(r32, (dd * 16 + hi * 8) * 2);
#pragma unroll
    for (int d0 = 0; d0 < 8; ++d0) { const char* a = kb[d0 & 3] + (d0 >> 2) * 128;
        bf16x8 b0 = *reinterpret_cast<const bf16x8*>(a);
        bf16x8 b1 = *reinterpret_cast<const bf16x8*>(a + 32 * 256);
        p0 = __builtin_amdgcn_mfma_f32_32x32x16_bf16(b0, qr[d0], p0, 0, 0, 0);
        p1 = __builtin_amdgcn_mfma_f32_32x32x16_bf16(b1, qr[d0], p1, 0, 0, 0); }
}
__device__ __forceinline__ void pv_tile(f32x16* o, int vb0, bf16x8 pa0, bf16x8 pa1, bf16x8 pa2, bf16x8 pa3) {
#define TRRD(dst, off) asm volatile("ds_read_b64_tr_b16 %0, %1 offset:%2" : "=&v"(dst) : "v"(vb0), "i"(off) : "memory")
#define PV_RD(d0, kh, X) do { constexpr int b_ = v_rd_off(d0, 2 * (kh), 0); TRRD(X##l0, b_); TRRD(X##h0, b_ + 2048); TRRD(X##l1, b_ + 4096); TRRD(X##h1, b_ + 6144); } while (0)
#define PV_MM(d0, X, PA, PB) do { \
        o[d0] = __builtin_amdgcn_mfma_f32_32x32x16_bf16(PA, (bf16x8){X##l0[0], X##l0[1], X##l0[2], X##l0[3], X##h0[0], X##h0[1], X##h0[2], X##h0[3]}, o[d0], 0, 0, 0);   \
        o[d0] = __builtin_amdgcn_mfma_f32_32x32x16_bf16(PB, (bf16x8){X##l1[0], X##l1[1], X##l1[2], X##l1[3], X##h1[0], X##h1[1], X##h1[2], X##h1[3]}, o[d0], 0, 0, 0); } while (0)
#define PV_W4() do { asm volatile("s_waitcnt lgkmcnt(4)" ::: "memory"); SBAR(); } while (0)
#define PV_W0() do { asm volatile("s_waitcnt lgkmcnt(0)" ::: "memory"); SBAR(); } while (0)
    s16x4 al0, al1, ah0, ah1, bl0, bl1, bh0, bh1;
    PV_RD(0, 0, a);
    PV_RD(0, 1, b); PV_W4(); PV_MM(0, a, pa0, pa1); SBAR();
    PV_RD(1, 0, a); PV_W4(); PV_MM(0, b, pa2, pa3); SBAR();
    PV_RD(1, 1, b); PV_W4(); PV_MM(1, a, pa0, pa1); SBAR();
    PV_RD(2, 0, a); PV_W4(); PV_MM(1, b, pa2, pa3); SBAR();
    PV_RD(2, 1, b); PV_W4(); PV_MM(2, a, pa0, pa1); SBAR();
    PV_RD(3, 0, a); PV_W4(); PV_MM(2, b, pa2, pa3); SBAR();
    PV_RD(3, 1, b); PV_W4(); PV_MM(3, a, pa0, pa1); SBAR();
    PV_W0(); PV_MM(3, b, pa2, pa3);
#undef PV_RD
#undef PV_MM
#undef PV_W4
#undef PV_W0
#undef TRRD
}

struct BlockRef { const bf16_t* Q; const bf16_t* K; const bf16_t* V; const bf16_t* Z; bf16_t* O; int P0; };
struct Seam { bf16x8 qr[8]; };
#define WAITV_BAR(N) asm volatile("s_waitcnt vmcnt(" #N ") lgkmcnt(0)\n\ts_barrier" ::: "memory")
struct DmaOff { unsigned k[2], v[2]; };
__device__ __forceinline__ DmaOff dma_offsets(int wid, int lane) {
    DmaOff d;
#pragma unroll
    for (int i = 0; i < 2; ++i) { const int pc = wid * 2 + i, q = pc * 64 + lane;
        const int row = q >> 4, j = (q & 15) ^ (row & 7); d.k[i] = (unsigned)(row * 256 + j * 16);
        const int s = q >> 5, w = q & 31, kk = (s >> 2) * 8 + (w >> 2), c = (s & 3) * 32 + (w & 3) * 8, k = (kk & ~0xC) | ((kk & 4) << 1) | ((kk & 8) >> 1);
        d.v[i] = (unsigned)(k * 256 + c * 2); }
    return d;
}
#define DMA_K(t, slot) do { _Pragma("unroll") for (int i_ = 0; i_ < 2; ++i_) __builtin_amdgcn_global_load_lds((const unsigned*)((const char*)Kh + (size_t)(t) * (KVBLK * D * 2) + dof.k[i_]), \
        (LAS unsigned*)((LAS unsigned char*)lds3 + OFF_K + (slot) + (wid * 2 + i_) * 1024), 16, 0, 0); } while (0)
#define DMA_V(t, slot) do { _Pragma("unroll") for (int i_ = 0; i_ < 2; ++i_) __builtin_amdgcn_global_load_lds((const unsigned*)((const char*)Vh + (size_t)(t) * (KVBLK * D * 2) + dof.v[i_]), \
        (LAS unsigned*)((LAS unsigned char*)lds3 + (slot) + (wid * 2 + i_) * 1024), 16, 0, 0); } while (0)
__device__ __forceinline__ void fox_prime(const BlockRef& cur, char* lds, Seam& S, const int tid) {
    const int wid = __builtin_amdgcn_readfirstlane(tid >> 6), lane = tid & 63, r32 = lane & 31, hi = lane >> 5;
    LAS unsigned char* lds3 = (LAS unsigned char*)lds; const DmaOff dof = dma_offsets(wid, lane);
    const bf16_t* Kh = cur.K; const bf16_t* Vh = cur.V;
#pragma unroll
    for (int d0 = 0; d0 < 8; ++d0) S.qr[d0] = load8(cur.Q + (size_t)(wid * QBLK + r32) * LD + d0 * 16 + hi * 8);
    SBAR(); DMA_K(0, 0); DMA_K(1, SLOT); DMA_V(0, 0); SBAR();
    WAITV_BAR(0);
}
__device__ __forceinline__ void fox_block(const BlockRef& cur, const BlockRef& nxt, char* lds, Seam& S, const int tid) {
    const int wid = __builtin_amdgcn_readfirstlane(tid >> 6), lane = tid & 63, r32 = lane & 31, hi = lane >> 5;
    const int NT = cur.P0 / KVBLK + 4;
    const int qlo = cur.P0 + wid * QBLK, qm = qlo + r32 - 4 * hi;
    char* V_lds = lds; char* K_lds = lds + OFF_K; LAS unsigned char* lds3 = (LAS unsigned char*)lds;
    float* ws = (float*)(lds + OFF_WS) + wid * 64; float* li_l = ws, * al_l = ws + 32;
    const LAS float* ctab = (const LAS float*)(LAS char*)(lds + OFF_C);
    float m_reg = -1e30f, l_reg = 0; f32x16 o[4] = {};
    const DmaOff dof = dma_offsets(wid, lane);
    const int vb0 = (int)(uintptr_t)V_lds + v_rd_base(lane);
    const bf16_t* Kh = cur.K; const bf16_t* Vh = cur.V;
#define RESC(a) do { if (__any((a) < 1.f)) { if (hi == 0) al_l[r32] = (a); asm volatile("s_waitcnt lgkmcnt(0)" ::: "memory");              \
                     for (int d_ = 0; d_ < 4; ++d_) for (int r = 0; r < 16; ++r) o[d_][r] *= al_l[crow(r, hi)]; } } while (0)
#define MASKT(P0_, P1_, t) do { const int kb_ = (t) * KVBLK; if (kb_ + KVBLK - 1 > qlo) mask_tile(P0_, P1_, qm - kb_); } while (0)
#define CTP(t) ((const LAS f32x4*)(ctab + (t) * KVBLK + 4 * hi))
#define ROT() do { s_prev = s_cur; s_cur = s_next; s_next = s_nn; s_nn = (s_nn == (NSLOT - 1) * SLOT) ? 0 : s_nn + SLOT; } while (0)
#define ENDW(t) do { if ((t) + 2 < NT) { WAITV_BAR(4); } else if ((t) + 1 < NT) { WAITV_BAR(2); } else { WAITV_BAR(0); } } while (0)
    f32x16 pA0, pA1, pB0, pB1; float mnA, mnB, alA, alB; bf16x8 pa0, pa1, pa2, pa3;
    int s_prev = 0, s_cur = 0, s_next = SLOT, s_nn = 2 * SLOT;
    SBAR(); DMA_K(2, s_nn); DMA_V(1, s_next); SBAR();
    qkt(pA0, pA1, K_lds + s_cur, r32, hi, S.qr, CTP(0));
    mask_meta(pA0, pA1); partialSM(pA0, pA1, m_reg, mnA, alA);
    SBAR(); WAITV_BAR(4);
    ROT();
#define STEP(PX0, PX1, mnX, alX, PY0, PY1, alY, t) do {                                                                       \
        SBAR(); if ((t) + 2 < NT) { DMA_K((t) + 2, s_nn); } if ((t) + 1 < NT) { DMA_V((t) + 1, s_next); }                     \
        SBAR(); qkt(PX0, PX1, K_lds + s_cur, r32, hi, S.qr, CTP(t));                                                          \
        finishSM(PY0, PY1, alY, l_reg, pa0, pa1, pa2, pa3); SBAR();                                                           \
        pv_tile(o, vb0 + s_prev, pa0, pa1, pa2, pa3); MASKT(PX0, PX1, (t)); partialSM(PX0, PX1, m_reg, mnX, alX);             \
        RESC(alX);                                                                                                            \
        SBAR(); ENDW(t);                                                                                                      \
        ROT(); } while (0)
    for (int t = 1; t + 1 < NT; t += 2) {
        STEP(pB0, pB1, mnB, alB, pA0, pA1, alA, t);
        STEP(pA0, pA1, mnA, alA, pB0, pB1, alB, t + 1);
    }
    finishSM(pA0, pA1, alA, l_reg, pa0, pa1, pa2, pa3); SBAR();
    pv_tile(o, vb0 + s_prev, pa0, pa1, pa2, pa3);
    SBAR(); WAITV_BAR(0);
    { const bf16_t* Kh = nxt.K; const bf16_t* Vh = nxt.V;
#pragma unroll
      for (int d0 = 0; d0 < 8; ++d0) S.qr[d0] = load8(nxt.Q + (size_t)(wid * QBLK + r32) * LD + d0 * 16 + hi * 8);
      SBAR(); DMA_K(0, 0); DMA_K(1, SLOT); DMA_V(0, 0); SBAR(); }
    if (hi == 0) li_l[r32] = l_reg; asm volatile("s_waitcnt lgkmcnt(0)" ::: "memory");
    float rli[16];
#pragma unroll
    for (int r = 0; r < 16; ++r) rli[r] = __builtin_amdgcn_rcpf(li_l[crow(r, hi)]);
    typedef __attribute__((address_space(1))) bf16_t gbf16; typedef __attribute__((address_space(1))) u32x4 gu32x4;
    LAS float* stg = (LAS float*)(lds3 + SLOT + wid * 4096);
    const int er = lane >> 2, eq = lane & 3;
    gbf16* obase = (gbf16*)(cur.O + (size_t)(wid * QBLK + er) * LD + 8 * eq); const gbf16* zbase = (const gbf16*)(cur.Z + (size_t)(wid * QBLK + er) * LD + 8 * eq);
#pragma unroll
    for (int d0 = 0; d0 < 4; ++d0) {
#pragma unroll
        for (int r = 0; r < 16; ++r) stg[crow(r, hi) * 32 + r32] = o[d0][r] * rli[r];
        asm volatile("s_waitcnt lgkmcnt(0)" ::: "memory");
        gbf16* op = obase; const gbf16* zp = zbase;
#pragma unroll
        for (int i = 0; i < 2; ++i) {
            asm volatile("" : "+v"(op), "+v"(zp));
            const f32x4 v0 = *(const LAS f32x4*)(stg + (er + 16 * i) * 32 + 8 * eq), v1 = *(const LAS f32x4*)(stg + (er + 16 * i) * 32 + 8 * eq + 4);
            const u32x4 z = __builtin_nontemporal_load((const gu32x4*)(zp + d0 * 32));
            u32x4 w; w.x = cvt_pk_bf16(v0.x * bf_lo(z.x), v0.y * bf_hi(z.x)); w.y = cvt_pk_bf16(v0.z * bf_lo(z.y), v0.w * bf_hi(z.y));
            w.z = cvt_pk_bf16(v1.x * bf_lo(z.z), v1.y * bf_hi(z.z)); w.w = cvt_pk_bf16(v1.z * bf_lo(z.w), v1.w * bf_hi(z.w));
            *(gu32x4*)(op + d0 * 32) = w;
            op += 16 * LD; zp += 16 * LD; }
        asm volatile("s_waitcnt lgkmcnt(0)" ::: "memory"); }
    WAITV_BAR(0);
#undef RESC
#undef MASKT
#undef CTP
#undef ROT
#undef ENDW
#undef STEP
}
#undef DMA_K
#undef DMA_V
#undef WAITV_BAR
#undef ROWP
#undef VMW
#undef VMWN
#undef SLOAD_H
#undef SWRITE_H
__device__ __forceinline__ void build_ctab(char* lds, const float* LFbh, const int tid) {
    const int lane = tid & 63, wid = tid >> 6;
    float* ctab = (float*)(lds + OFF_C); float* red = (float*)(lds + OFF_RED);
    constexpr int PER = 9; const int e0 = tid * PER;
    float v[PER]; float s = 0.f;
#pragma unroll
    for (int i = 0; i < PER; ++i) { const int kk = e0 + i; float x = 0.f; if (kk >= 48 && kk < KVROWS) x = LFbh[kk]; s += x; v[i] = s; }
    float incl = s;
#pragma unroll
    for (int off = 1; off < 64; off <<= 1) { const float t = __shfl_up(incl, off); if (lane >= off) incl += t; }
    if (lane == 63) red[wid] = incl;
    __syncthreads();
    float base = incl - s;
    for (int w = 0; w < wid; ++w) base += red[w];
#pragma unroll
    for (int i = 0; i < PER; ++i) { const int kk = e0 + i; if (kk < KVROWS) ctab[kk] = -(base + v[i]); }
    __syncthreads();
}
struct Tensors { const bf16_t* Q; const bf16_t* K; const bf16_t* V; const bf16_t* Z; bf16_t* O; const float* LF; };
__device__ __forceinline__ BlockRef mkref(const Tensors& T, int b, int h, int qb) {
    BlockRef r; const size_t qo = (size_t)(b * SEQ + qb * QB) * LD + h * D, ko = (size_t)(b * NH + h) * KVROWS * D;
    r.Q = T.Q + qo; r.Z = T.Z + qo; r.O = T.O + qo; r.K = T.K + ko; r.V = T.V + ko; r.P0 = 64 + qb * QB; return r;
}
__device__ __forceinline__ void attn_phase(char* lds, const Tensors& T, int vcu, int G) {
    for (int L = vcu; L < NB * NH * 8; L += G) {
        const int bh = L >> 3, x = L & 7, b = bh >> 4, h = bh & 15;
        int tid = threadIdx.x; asm volatile("" : "+v"(tid));
        build_ctab(lds, T.LF + (size_t)(b * NH + h) * KVROWS, tid);
        const BlockRef r0 = mkref(T, b, h, 15 - x), r1 = mkref(T, b, h, x);
        Seam S;
        fox_prime(r0, lds, S, tid);
        fox_block(r0, r1, lds, S, tid);
        fox_block(r1, r1, lds, S, tid);
    }
}
#undef SBAR
#undef KSWZ
}

constexpr int NWAVES = 8, NTHREADS = 512;
constexpr int LDS_BYTES = 147456;
static_assert(att::LDS_BYTES <= 131072 && pg8::STAGE_BYTES <= 131072, "LDS map");

struct Args { const float* in[10]; float* out; unsigned char* ws; int ph_lo, ph_hi; };

__device__ __forceinline__ unsigned f2bf(float f) { unsigned u = __builtin_bit_cast(unsigned, f); return (u + 0x7fffu + ((u >> 16) & 1u)) >> 16; }
__device__ __forceinline__ unsigned pk2(float lo, float hi) { return cvt_pk_bf16(lo, hi); }
__device__ __forceinline__ float wave_sum(float v) {
#pragma unroll
    for (int o = 1; o < 64; o <<= 1) v += __shfl_xor(v, o);
    return v;
}
__device__ __forceinline__ int src_col_of_dst(int r0) {
    if (r0 < 6144) return r0;
    if (r0 < 8192) return r0 + 16;
    if (r0 < 12288) { const int p = (r0 - 8192) >> 8, w = (r0 - 8192) & 255; return (w < 128 ? 8208 : 12304) + 128 * p + (w & 127); }
    if (r0 < 16384) { const int p = (r0 - 12288) >> 8, w = (r0 - 12288) & 255; return (w < 128 ? 10256 : 14352) + 128 * p + (w & 127); }
    if (r0 < 20480) { const int p = (r0 - 16384) >> 8, w = (r0 - 16384) & 255; return (w < 128 ? 16400 : 18448) + 128 * p + (w & 127); }
    return 6144;
}
struct TrItem { const float* src; bf16_t* dst; int ldn, nvalid4; };
__device__ __forceinline__ void tr_load(f32x4 (&v)[16], const TrItem& t, int lane) {
    const int ks = lane >> 4, g = lane & 15;
#pragma unroll
    for (int i = 0; i < 16; ++i) v[i] = (g < t.nvalid4) ? __builtin_nontemporal_load((const f32x4*)(t.src + (size_t)(4 * i + ks) * t.ldn + 4 * g)) : (f32x4){0.f, 0.f, 0.f, 0.f};
}
__device__ __forceinline__ void tr_process(const f32x4 (&v)[16], const TrItem& t, LAS float* scr, int lane) {
    const int ks = lane >> 4, g = lane & 15;
#pragma unroll
    for (int i = 0; i < 16; ++i) { LAS float* w = scr + (4 * i + ks) * 65 + 4 * g; w[0] = v[i].x; w[1] = v[i].y; w[2] = v[i].z; w[3] = v[i].w; }
    asm volatile("s_waitcnt lgkmcnt(0)" ::: "memory");
    const int c = lane & 7;
#pragma unroll
    for (int j = 0; j < 8; ++j) { const int n = (lane >> 3) + 8 * j; const LAS float* s = scr + (8 * c) * 65 + n;
        u32x4 o; o.x = pk2(s[0 * 65], s[1 * 65]); o.y = pk2(s[2 * 65], s[3 * 65]); o.z = pk2(s[4 * 65], s[5 * 65]); o.w = pk2(s[6 * 65], s[7 * 65]);
        if (n < 4 * t.nvalid4 || t.nvalid4 == 16) *(u32x4*)(t.dst + (size_t)n * 2048 + 8 * c) = o; }
    asm volatile("s_waitcnt lgkmcnt(0)" ::: "memory");
}
__device__ __forceinline__ void rms_rows2_to_bf16(const float* xa, bf16_t* oa, const float* xb, bf16_t* ob, bool hasb, const float* gain, int lane) {
    const f32x4* ra = (const f32x4*)xa + lane; const f32x4* rb = (const f32x4*)(hasb ? xb : xa) + lane; const f32x4* gr = (const f32x4*)gain + lane;
    f32x4 v[8], w[8]; float s = 0.f, s2 = 0.f;
#pragma unroll
    for (int j = 0; j < 8; ++j) v[j] = __builtin_nontemporal_load(ra + 64 * j);
#pragma unroll
    for (int j = 0; j < 8; ++j) w[j] = __builtin_nontemporal_load(rb + 64 * j);
#pragma unroll
    for (int j = 0; j < 8; ++j) { s += (v[j].x * v[j].x + v[j].y * v[j].y) + (v[j].z * v[j].z + v[j].w * v[j].w); s2 += (w[j].x * w[j].x + w[j].y * w[j].y) + (w[j].z * w[j].z + w[j].w * w[j].w); }
    const float rstd = 1.0f / sqrtf(wave_sum(s) * (1.f / DM) + EPS), rstd2 = 1.0f / sqrtf(wave_sum(s2) * (1.f / DM) + EPS);
    unsigned long long* o8 = (unsigned long long*)oa + lane; unsigned long long* p8 = (unsigned long long*)ob + lane;
#pragma unroll
    for (int j = 0; j < 8; ++j) { const f32x4 g = gr[64 * j]; const f32x4 y = v[j] * rstd * g, z = w[j] * rstd2 * g;
        o8[64 * j] = (unsigned long long)pk2(y.x, y.y) | ((unsigned long long)pk2(y.z, y.w) << 32);
        if (hasb) p8[64 * j] = (unsigned long long)pk2(z.x, z.y) | ((unsigned long long)pk2(z.z, z.w) << 32); }
}
__device__ __forceinline__ void zero_bytes16(void* p, size_t nbytes, int gt, int ngt) {
    u32x4* q = (u32x4*)p; const size_t n = nbytes / 16;
    for (size_t i = gt; i < n; i += ngt) q[i] = (u32x4){0u, 0u, 0u, 0u};
}

__device__ __forceinline__ void p1_side_task(int c, LAS unsigned char* lds, const bf16_t* XN, const bf16_t* WIN, const float* b_f, float* LF, bf16_t* Kb, bf16_t* Vb, bf16_t* P1b) {
    const int tid = threadIdx.x, lane = tid & 63, w = __builtin_amdgcn_readfirstlane(tid >> 6), fr = lane & 15, fq = lane >> 4;
    const bf16_t* XM = XN + (size_t)MREAL * DM;
    const bf16_t* WF = WIN + (size_t)20480 * DM;
    int n0, n1;
    if (c < 64) { n0 = 2048 + 32 * c; n1 = n0 + 16; } else if (c < 128) { n0 = 4096 + 32 * (c - 64); n1 = n0 + 16; }
    else { const int ch0 = 16 * (c - 128); n0 = 8192 + 256 * (ch0 >> 7) + (ch0 & 127); n1 = n0 + 128; }
    const size_t lo_ = (size_t)fr * DM + 256 * w + 8 * fq;
    const bf16_t* P6[6] = {XN + (size_t)(32 * c) * DM + lo_, XN + (size_t)(32 * c + 16) * DM + lo_, XM + lo_, WF + lo_, WIN + (size_t)n0 * DM + lo_, WIN + (size_t)n1 * DM + lo_};
    bf16x8 fr6[6][8];
#pragma unroll
    for (int s = 0; s < 6; ++s)
#pragma unroll
        for (int i = 0; i < 8; ++i) fr6[s][i] = *(const bf16x8*)(P6[s] + 32 * i);
    f32x4 acc[5];
#pragma unroll
    for (int g = 0; g < 5; ++g) acc[g] = (f32x4){0.f, 0.f, 0.f, 0.f};
#pragma unroll
    for (int i = 0; i < 8; ++i) {
        acc[0] = __builtin_amdgcn_mfma_f32_16x16x32_bf16(fr6[0][i], fr6[3][i], acc[0], 0, 0, 0);
        acc[1] = __builtin_amdgcn_mfma_f32_16x16x32_bf16(fr6[1][i], fr6[3][i], acc[1], 0, 0, 0);
        acc[2] = __builtin_amdgcn_mfma_f32_16x16x32_bf16(fr6[2][i], fr6[3][i], acc[2], 0, 0, 0);
        acc[3] = __builtin_amdgcn_mfma_f32_16x16x32_bf16(fr6[4][i], fr6[2][i], acc[3], 0, 0, 0);
        acc[4] = __builtin_amdgcn_mfma_f32_16x16x32_bf16(fr6[5][i], fr6[2][i], acc[4], 0, 0, 0);
    }
    LAS f32x4* red = (LAS f32x4*)lds;
#pragma unroll
    for (int g = 0; g < 5; ++g) red[(w * 5 + g) * 64 + lane] = acc[g];
    __syncthreads();
    if (w == 0) {
#pragma unroll
        for (int g = 0; g < 5; ++g) { f32x4 s = red[g * 64 + lane];
#pragma unroll
            for (int ww = 1; ww < 8; ++ww) s += red[(ww * 5 + g) * 64 + lane];
            acc[g] = s; }
        const float bfh = b_f[fr];
#pragma unroll
        for (int g = 0; g < 3; ++g)
#pragma unroll
            for (int j = 0; j < 4; ++j) { const float xx = acc[g][j] + bfh; const float v = (fminf(xx, 0.f) - log1pf(__expf(-fabsf(xx)))) * LOG2E; const int m = 4 * fq + j;
                if (g < 2) { const int row = 32 * c + 16 * g + m; LF[(size_t)((row >> 12) * NH + fr) * KVROWS + 64 + (row & 4095)] = v; }
                else if (c == 0) { LF[(size_t)fr * KVROWS + 48 + m] = v; LF[(size_t)(NH + fr) * KVROWS + 48 + m] = v; } }
        if (c < 128) {
            bf16_t* T = (c < 64) ? Kb : Vb; const int col0 = (c < 64) ? 32 * c : 32 * (c - 64);
#pragma unroll
            for (int g = 0; g < 2; ++g)
#pragma unroll
                for (int j = 0; j < 4; ++j) { const bf16_t v = (bf16_t)(cvt_pk_bf16(acc[3 + g][j], 0.f) & 0xffffu); const int col = col0 + 16 * g + 4 * fq + j;
                    const size_t o_ = ((size_t)(col >> 7) * KVROWS + 48 + fr) * HD + (col & 127); T[o_] = v; T[o_ + (size_t)NH * KVROWS * HD] = v; }
        } else if (fr >= 14) {
            const int ch0 = 16 * (c - 128);
#pragma unroll
            for (int j = 0; j < 4; ++j) { const bf16_t v = (bf16_t)(cvt_pk_bf16(acc[3][j] * acc[4][j], 0.f) & 0xffffu); const int col = ch0 + 4 * fq + j;
                P1b[(size_t)(fr - 14) * DM + col] = v; P1b[(size_t)(P1ROWS + fr - 14) * DM + col] = v; }
        }
    }
    __syncthreads();
}

#define XB_TMO      128
#define XB_XCNT(j)  (256  + 64 * (j))
#define XB_XSUB(j)  (1280 + 64 * (j))
#define XB_XGEN(j)  (2304 + 64 * (j))
#define XB_TOP      3328
#define XB_TOPGEN   3392
#define XCD_BAR_WORDS 3456
#define XB_SPIN_CAP (1u << 22)
__device__ __forceinline__ unsigned xb_ld(unsigned* p)              { return __hip_atomic_load(p, __ATOMIC_RELAXED, __HIP_MEMORY_SCOPE_AGENT); }
__device__ __forceinline__ unsigned xb_add(unsigned* p, unsigned v) { return __hip_atomic_fetch_add(p, v, __ATOMIC_RELAXED, __HIP_MEMORY_SCOPE_AGENT); }
__device__ __forceinline__ unsigned xb_xcc_id() { return (unsigned)__builtin_amdgcn_s_getreg((3 << 11) | 20) & 0xFu; }
#define XB_SPIN(cond, bar) do { unsigned _sp = 0; while (cond) { __builtin_amdgcn_s_sleep(1); \
    if ((++_sp & 255u) == 0u) { if (xb_ld(&(bar)[XB_TMO])) break; if (_sp > XB_SPIN_CAP) { atomicAdd(&(bar)[XB_TMO], 1u); break; } } } } while (0)
struct XcdBarrier { unsigned* bar; unsigned x; volatile LAS unsigned* st; };
__device__ __forceinline__ XcdBarrier xcd_barrier_post(unsigned* bar, volatile LAS unsigned* st) {
    XcdBarrier b; b.bar = bar; b.x = xb_xcc_id(); b.st = st;
    if (threadIdx.x == 0) (void)xb_add(&bar[XB_XCNT(b.x)], 1u);
    return b;
}
__device__ __forceinline__ void xcd_barrier_complete(unsigned* bar, unsigned x, unsigned& nloc, unsigned& nx) {
    const unsigned G = gridDim.x * gridDim.y * gridDim.z;
    unsigned sum, cnt, mine, sp = 0u;
    for (;;) {
        sum = 0u; cnt = 0u; mine = 0u;
#pragma unroll
        for (unsigned j = 0; j < 16; ++j) { const unsigned c = xb_ld(&bar[XB_XCNT(j)]); sum += c; cnt += (c > 0u) ? 1u : 0u; mine = (j == x) ? c : mine; }
        if (sum == G) break;
        __builtin_amdgcn_s_sleep(1);
        if ((++sp & 255u) == 0u) { if (xb_ld(&bar[XB_TMO])) break; if (sp > XB_SPIN_CAP) { atomicAdd(&bar[XB_TMO], 1u); break; } }
    }
    nloc = mine > 0u ? mine : 1u; nx = cnt > 0u ? cnt : 1u;
}
__device__ __forceinline__ void xcd_barrier(const XcdBarrier& b) {
    asm volatile("s_waitcnt vmcnt(0)" ::: "memory");
    __syncthreads();
    if (threadIdx.x == 0) {
        unsigned* bar = b.bar;
        __builtin_amdgcn_s_waitcnt(0);
        unsigned nloc = b.st[0], nx = b.st[1];
        if (nloc == 0u) { xcd_barrier_complete(bar, b.x, nloc, nx); b.st[0] = nloc; b.st[1] = nx; }
        const unsigned old = xb_add(&bar[XB_XSUB(b.x)], 1u);
        const unsigned gen = old / nloc;
        if (old + 1u == (gen + 1u) * nloc) {
            __builtin_amdgcn_fence(__ATOMIC_RELEASE, "agent");
            asm volatile("s_waitcnt vmcnt(0)" ::: "memory");
            const unsigned og = xb_add(&bar[XB_TOP], 1u);
            const unsigned tg = og / nx;
            if (og + 1u == (tg + 1u) * nx) xb_add(&bar[XB_TOPGEN], 1u);
            else XB_SPIN(xb_ld(&bar[XB_TOPGEN]) == tg, bar);
            __builtin_amdgcn_fence(__ATOMIC_ACQUIRE, "agent");
            xb_add(&bar[XB_XGEN(b.x)], 1u);
            asm volatile("s_waitcnt vmcnt(0)" ::: "memory");
        } else {
            XB_SPIN(xb_ld(&bar[XB_XGEN(b.x)]) == gen, bar);
            __builtin_amdgcn_fence(__ATOMIC_ACQUIRE, "agent");
            asm volatile("s_waitcnt vmcnt(0)" ::: "memory");
        }
    }
    __syncthreads();
}

__device__ __forceinline__ void grid_barrier(unsigned* ctr, unsigned target) {
    asm volatile("s_waitcnt vmcnt(0)" ::: "memory");
    __syncthreads();
    if (threadIdx.x == 0) {
        __builtin_amdgcn_fence(__ATOMIC_RELEASE, "agent");
        asm volatile("s_waitcnt vmcnt(0)" ::: "memory");
        __hip_atomic_fetch_add(ctr, 1u, __ATOMIC_RELAXED, __HIP_MEMORY_SCOPE_AGENT);
        while (__hip_atomic_load(ctr, __ATOMIC_RELAXED, __HIP_MEMORY_SCOPE_AGENT) < target) __builtin_amdgcn_s_sleep(2);
        __builtin_amdgcn_fence(__ATOMIC_ACQUIRE, "agent");
        asm volatile("s_waitcnt vmcnt(0)" ::: "memory");
    }
    __syncthreads();
}

__global__ void __launch_bounds__(NTHREADS, 2) fox_fwd(Args args) {
    extern __shared__ __attribute__((aligned(16))) unsigned char lds[];
    if (args.ph_lo < 0) cg::this_grid().sync();
#define tid ((int)threadIdx.x)
#define lane (tid & 63)
    const int wave = __builtin_amdgcn_readfirstlane(tid >> 6);
    const int G = gridDim.x, bx = blockIdx.x, vcu = (G % 8 == 0) ? (bx % 8) * (G / 8) + bx / 8 : bx;
    unsigned char* ws = args.ws;
    const float* x = args.in[0]; const float* meta = args.in[1]; const float* norm_gain = args.in[2]; const float* w_in = args.in[3];
    const float* b_f = args.in[4]; const float* conv_w = args.in[5]; const float* w_att_o = args.in[6]; const float* w_conv_o = args.in[7];
    const float* w_out = args.in[8]; const float* final_gain = args.in[9];
    bf16_t* WIN = (bf16_t*)(ws + WS_WIN); bf16_t* WATT = (bf16_t*)(ws + WS_WATT); bf16_t* WCONV = (bf16_t*)(ws + WS_WCONV); bf16_t* WOUT = (bf16_t*)(ws + WS_WOUT);
    bf16_t* XN = (bf16_t*)(ws + WS_XN); bf16_t* Qb = (bf16_t*)(ws + WS_Q); bf16_t* Kb = (bf16_t*)(ws + WS_K); bf16_t* Vb = (bf16_t*)(ws + WS_V);
    bf16_t* Zb = (bf16_t*)(ws + WS_Z); bf16_t* P1b = (bf16_t*)(ws + WS_P1); bf16_t* P2b = (bf16_t*)(ws + WS_P2); bf16_t* Rb = (bf16_t*)(ws + WS_R);
    bf16_t* S2b = (bf16_t*)(ws + WS_S2); bf16_t* AATT = (bf16_t*)(ws + WS_AATT); bf16_t* ACONV = (bf16_t*)(ws + WS_ACONV); bf16_t* MG = (bf16_t*)(ws + WS_MG);
    float* LF = (float*)(ws + WS_LF); float* SS = (float*)(ws + WS_SS);
    const int lo = args.ph_lo, hi = args.ph_hi;
    volatile LAS unsigned* xst = (volatile LAS unsigned*)((LAS unsigned char*)lds + LDS_BYTES - 64);
    if (tid < 16) xst[tid] = 0u;
    __syncthreads();
    XcdBarrier xbar; xbar.bar = (unsigned*)(ws + WS_CTL) + 8192; xbar.x = 0; xbar.st = xst;
    if (hi - lo > 1) xbar = xcd_barrier_post((unsigned*)(ws + WS_CTL) + 8192, xst);
#define IN(k) (lo <= (k) && (k) < hi)
#define SEAM(k) do { if (IN(k) && IN((k) + 1)) { xcd_barrier(xbar); } } while (0)
#define REP(k) for (int rep_ = 0; rep_ < ((PROBE_REPEAT == (k)) ? 2 : 1); ++rep_)
#define REPBAR(k) do { if (PROBE_REPEAT == (k) && rep_ == 0) grid_barrier((unsigned*)(ws + WS_CTL) + 64 * (8 + (k)), (unsigned)G); } while (0)
    const int gw = vcu * NWAVES + wave, NGW = G * NWAVES, ngt = G * NTHREADS;
#define gt (bx * NTHREADS + tid)

    if (IN(0)) REP(0) {
        LAS float* scr = (LAS float*)((LAS unsigned char*)lds + wave * 16640);
        constexpr int NG_IN = 321, I_IN = NG_IN * 32, I_SQ = 32 * 32, NITEMS = I_IN + 3 * I_SQ;
#define TR_DECODE(T_, it_) do { int r_ = (it_); if (r_ < I_IN) { const bool tail_ = r_ >= 320 * 32; const int kb = tail_ ? (r_ - 320 * 32) : (((r_ >> 2) & 1) | (((r_ >> 3) & 15) << 1)), grp = tail_ ? 320 : ((r_ & 3) | ((r_ >> 7) << 2)); T_.src = w_in + (size_t)(kb * 64) * N_IN + src_col_of_dst(grp * 64); T_.dst = WIN + (size_t)(grp * 64) * 2048 + kb * 64; T_.ldn = N_IN; T_.nvalid4 = (grp == 320) ? 4 : 16; } \
            else { r_ -= I_IN; const int which = r_ / I_SQ; r_ -= which * I_SQ; const int kb = ((r_ >> 2) & 1) | (((r_ >> 3) & 15) << 1), grp = (r_ & 3) | ((r_ >> 7) << 2); T_.src = (which == 0 ? w_att_o : which == 1 ? w_conv_o : w_out) + (size_t)(kb * 64) * DM + grp * 64; \
                   T_.dst = (which == 0 ? WATT : which == 1 ? WCONV : WOUT) + (size_t)(grp * 64) * 2048 + kb * 64; T_.ldn = DM; T_.nvalid4 = 16; } } while (0)
        {
            f32x4 va[16], vb[16]; TrItem ta, tb; int it = gw;
            if (it < NITEMS) { TR_DECODE(ta, it); tr_load(va, ta, lane); }
            while (it < NITEMS) {
                int it2 = it + NGW; if (it2 < NITEMS) { TR_DECODE(tb, it2); tr_load(vb, tb, lane); }
                tr_process(va, ta, scr, lane);
                it = it2; if (it >= NITEMS) break;
                it2 = it + NGW; if (it2 < NITEMS) { TR_DECODE(ta, it2); tr_load(va, ta, lane); }
                tr_process(vb, tb, scr, lane);
                it = it2;
            }
        }
#undef TR_DECODE
        for (int m = gw; m < MREAL + NMETA; m += 2 * NGW) { const int m2 = m + NGW;
            rms_rows2_to_bf16(m < MREAL ? x + (size_t)m * DM : meta + (size_t)(m - MREAL) * DM, XN + (size_t)m * DM,
                              m2 < MREAL ? x + (size_t)m2 * DM : meta + (size_t)(m2 - MREAL) * DM, XN + (size_t)m2 * DM, m2 < MREAL + NMETA, norm_gain, lane); }
        for (int bh = 0; bh < NB * NH; ++bh) { zero_bytes16(Kb + (size_t)bh * KVROWS * HD, (size_t)48 * HD * 2, gt, ngt); zero_bytes16(Vb + (size_t)bh * KVROWS * HD, (size_t)48 * HD * 2, gt, ngt); }
        REPBAR(0);
    }
    SEAM(0);
    if (IN(1)) REP(1) {
        pg8::Gemm g{XN, WIN, nullptr, nullptr, MREAL, 20480, DM}; pg8::StaticOrder<1> S; S.init(MREAL, 20480, G, bx);
        pg8::EpiProj E{Qb, Kb, Vb, Zb, P1b, P2b, Rb, S2b};
        pg8::gemm_phase<pg8::EpiProj, pg8::StaticOrder<1>, 1>((LAS unsigned char*)lds, g, S, E);
        for (int srep = 0; srep < SIDE_REPS; ++srep) for (int c = bx; c < 256; c += G) p1_side_task(c, (LAS unsigned char*)lds, XN, WIN, b_f, LF, Kb, Vb, P1b);
        REPBAR(1);
    }
    SEAM(1);
    if (IN(2)) REP(2) {
        const att::Tensors T{Qb, Kb, Vb, Zb, AATT, LF};
        att::attn_phase((char*)lds, T, vcu, G);
        for (int idx = gt; idx < MREAL * 256; idx += ngt) {
            const int row = idx >> 8, ch = (idx & 255) * 8, b = row >> 12; const size_t pr = (size_t)(row + 2 * b) * DM + ch;
            const u32x4 a0 = *(const u32x4*)(P1b + pr), a1 = *(const u32x4*)(P1b + pr + DM), a2 = *(const u32x4*)(P1b + pr + 2 * DM), gg = *(const u32x4*)(P2b + (size_t)row * DM + ch);
            const f32x4 w0a = *(const f32x4*)(conv_w + ch), w0b = *(const f32x4*)(conv_w + ch + 4), w1a = *(const f32x4*)(conv_w + DM + ch), w1b = *(const f32x4*)(conv_w + DM + ch + 4),
                        w2a = *(const f32x4*)(conv_w + 2 * DM + ch), w2b = *(const f32x4*)(conv_w + 2 * DM + ch + 4);
            u32x4 o;
#define CONV2(W, A0, A1, A2, GW, wa, wb, wc_, j0) W = cvt_pk_bf16(bf_lo(GW) * (wa[j0] * bf_lo(A0) + wb[j0] * bf_lo(A1) + wc_[j0] * bf_lo(A2)), bf_hi(GW) * (wa[j0 + 1] * bf_hi(A0) + wb[j0 + 1] * bf_hi(A1) + wc_[j0 + 1] * bf_hi(A2)))
            CONV2(o.x, a0.x, a1.x, a2.x, gg.x, w0a, w1a, w2a, 0); CONV2(o.y, a0.y, a1.y, a2.y, gg.y, w0a, w1a, w2a, 2);
            CONV2(o.z, a0.z, a1.z, a2.z, gg.z, w0b, w1b, w2b, 0); CONV2(o.w, a0.w, a1.w, a2.w, gg.w, w0b, w1b, w2b, 2);
#undef CONV2
            *(u32x4*)(ACONV + (size_t)row * DM + ch) = o;
        }
        REPBAR(2);
    }
    SEAM(2);
    if (IN(3)) REP(3) {
        pg8::Gemm g{AATT, WATT, ACONV, WCONV, MREAL, DM, DM}; pg8::StaticOrder<2> S; S.init(MREAL, DM, G, bx);
        pg8::EpiMerge E{Rb, S2b, MG};
        pg8::gemm_phase<pg8::EpiMerge, pg8::StaticOrder<2>, 2>((LAS unsigned char*)lds, g, S, E);
        REPBAR(3);
    }
    SEAM(3);
    const bool fused_norm = (G == 256) && IN(4) && IN(5);
    if (IN(4)) {
        pg8::Gemm g{MG, WOUT, nullptr, nullptr, MREAL, DM, DM}; pg8::StaticOrder<1> S; S.init(MREAL, DM, G, bx);
        if (fused_norm) { pg8::EpiOutNorm E{x, args.out, final_gain, SS, (unsigned*)(ws + WS_CTL) + 2048};
            pg8::gemm_phase<pg8::EpiOutNorm, pg8::StaticOrder<1>, 1, false, true>((LAS unsigned char*)lds, g, S, E); }
        else { pg8::EpiOut E{x, args.out, SS};
            pg8::gemm_phase<pg8::EpiOut, pg8::StaticOrder<1>, 1>((LAS unsigned char*)lds, g, S, E); }
    }
    if (!fused_norm) {
    SEAM(4);
    if (IN(5)) {
        for (int m = gw; m < MREAL; m += NGW) {
            float s = (lane < 32) ? SS[(size_t)m * 32 + lane] : 0.f; s = wave_sum(s);
            const float rstd = 1.0f / sqrtf(s * (1.f / DM) + EPS);
            f32x4* o = (f32x4*)(args.out + (size_t)m * DM) + lane; const f32x4* gr = (const f32x4*)final_gain + lane;
#pragma unroll
            for (int j = 0; j < 8; ++j) { const f32x4 y = o[64 * j]; o[64 * j] = y * rstd * gr[64 * j]; }
        }
    }
    }
#undef IN
#undef SEAM
#undef REP
#undef REPBAR
#undef tid
#undef lane
#undef gt
}

extern "C" void kernel_launch(void* const* d_in, const int* in_sizes, int n_in, void* d_out, int out_size, void* d_ws, size_t ws_size, hipStream_t stream) {
    static int grid = 0;
    if (grid == 0) {
        if (n_in != 10 || in_sizes[0] != MREAL * DM || out_size != MREAL * DM || ws_size < WS_END) {
            fprintf(stderr, "kernel_launch: unexpected shapes (n_in %d, in0 %d, out %d, ws %zu < %zu?)\n", n_in, n_in > 0 ? in_sizes[0] : -1, out_size, ws_size, (size_t)WS_END); grid = -1; return; }
        int dev = 0, cus = 0, per_cu = 0;
        (void)hipGetDevice(&dev); (void)hipDeviceGetAttribute(&cus, hipDeviceAttributeMultiprocessorCount, dev);
        if (hipFuncSetAttribute((const void*)fox_fwd, hipFuncAttributeMaxDynamicSharedMemorySize, LDS_BYTES) != hipSuccess) { fprintf(stderr, "kernel_launch: hipFuncSetAttribute failed\n"); grid = -1; return; }
        if (hipOccupancyMaxActiveBlocksPerMultiprocessor(&per_cu, (const void*)fox_fwd, NTHREADS, LDS_BYTES) != hipSuccess || per_cu < 1) { fprintf(stderr, "kernel_launch: occupancy query says %d\n", per_cu); per_cu = 1; }
        (void)hipGetLastError();
        if (cus <= 0) cus = 256;
        grid = cus;
    }
    if (grid < 0) return;
    Args a{};
    for (int i = 0; i < 10; ++i) a.in[i] = (const float*)d_in[i];
    a.out = (float*)d_out; a.ws = (unsigned char*)d_ws;
#if MK_COOP
    a.ph_lo = 0; a.ph_hi = 6;
    (void)hipMemsetAsync((unsigned char*)d_ws + WS_CTL, 0, 65536, stream);
    void* kargs[] = {&a};
    hipError_t e = hipLaunchCooperativeKernel((const void*)fox_fwd, dim3(grid), dim3(NTHREADS), kargs, LDS_BYTES, stream);
    if (e != hipSuccess) fprintf(stderr, "kernel_launch: cooperative launch failed: %s (grid %d)\n", hipGetErrorString(e), grid);
#else
    for (int p = 0; p < 6; ++p) { a.ph_lo = p; a.ph_hi = p + 1; hipLaunchKernelGGL(fox_fwd, dim3(grid), dim3(NTHREADS), LDS_BYTES, stream, a); }
#endif
}
```

```cpp
#include <hip/hip_runtime.h>
#include <hip/hip_cooperative_groups.h>
#include <cstdio>
#include <cstdint>
namespace cg = cooperative_groups;

#ifndef PROBE_REPEAT
#define PROBE_REPEAT -1
#endif
#ifndef SIDE_REPS
#define SIDE_REPS 1
#endif
#ifndef MK_COOP
#define MK_COOP 1
#endif

#define LAS __attribute__((address_space(3)))
typedef unsigned short bf16_t;
typedef short bf16x8 __attribute__((ext_vector_type(8)));
typedef short s16x4 __attribute__((ext_vector_type(4)));
typedef float f32x4 __attribute__((ext_vector_type(4)));
typedef float f32x2 __attribute__((ext_vector_type(2)));
typedef float f32x16 __attribute__((ext_vector_type(16)));
typedef unsigned u32x4 __attribute__((ext_vector_type(4)));
typedef unsigned u32x2 __attribute__((ext_vector_type(2)));

constexpr int DM = 2048, NB = 2, SEQ = 4096, NMETA = 16, NH = 16, HD = 128;
constexpr int MREAL = NB * SEQ;
constexpr int MALL = MREAL + 256;
constexpr int N_IN = 20496;
constexpr int NPROJ = 81 * 256;
constexpr int KVROWS = 64 + SEQ;
constexpr int P1ROWS = 2 + SEQ;
constexpr float EPS = 1e-6f;
constexpr float LOG2E = 1.4426950408889634f;
constexpr float QSCALE = 0.08838834764831845f * 1.4426950408889634f;

constexpr size_t MiB = 1u << 20;
constexpr size_t WS_WIN = 0, WS_WATT = 81 * MiB, WS_WCONV = 89 * MiB, WS_WOUT = 97 * MiB, WS_XN = 105 * MiB, WS_Q = 138 * MiB,
                 WS_K = 170 * MiB, WS_V = 203 * MiB, WS_Z = 236 * MiB, WS_P1 = 268 * MiB, WS_P2 = 301 * MiB, WS_R = 333 * MiB,
                 WS_S2 = 365 * MiB, WS_AATT = 397 * MiB, WS_ACONV = 429 * MiB, WS_MG = 461 * MiB, WS_LF = 493 * MiB, WS_SS = 494 * MiB,
                 WS_CTL = 495 * MiB, WS_END = 496 * MiB;

__device__ __forceinline__ unsigned cvt_pk_bf16(float lo, float hi) { unsigned r; asm volatile("v_cvt_pk_bf16_f32 %0, %1, %2" : "=v"(r) : "v"(lo), "v"(hi)); return r; }
__device__ __forceinline__ float bf_lo(unsigned w) { return __uint_as_float(w << 16); }
__device__ __forceinline__ float bf_hi(unsigned w) { return __uint_as_float(w & 0xffff0000u); }
__device__ __forceinline__ float sigmoidf_(float x) { return __builtin_amdgcn_rcpf(1.0f + __expf(-x)); }
__device__ __forceinline__ float siluf_(float x) { return x * sigmoidf_(x); }

namespace pg8 {
constexpr int BM = 256, BK = 64, HALF = 128, HTB = HALF * BK * 2, STAGE_BYTES = 8 * HTB, NXCD = 8, WGM = 8;
__host__ __device__ __forceinline__ int lds_byte(int r, int c) { const int st = (r >> 4) * 2 + (c >> 5), rr = r & 15, cc = c & 31, ob = rr * 64 + cc * 2; return st * 1024 + (ob ^ (((ob >> 9) & 1) << 5)); }
__host__ __device__ __forceinline__ void stage_rc(int b, int& R, int& C) { const int st = b / 1024, sb = b % 1024, swz = sb ^ (((sb >> 9) & 1) << 5); R = (st >> 1) * 16 + swz / 64; C = (st & 1) * 32 + (swz % 64) / 2; }
__host__ __device__ __forceinline__ int perm32(int rho) { const int n = rho >> 4, i = rho & 15; return 8 * (i >> 2) + 4 * n + (i & 3); }

struct Unit { int pm, pn, seg; };
struct Gemm { const bf16_t* A; const bf16_t* Bt; const bf16_t* A2; const bf16_t* Bt2; int M, N, K; };

template <int NSEG> struct StaticOrder {
    int nM, nN, nwg, G, c;
    __device__ void init(int M, int N, int G_, int c_) { nM = M / BM; nN = N / BM; nwg = nM * nN; G = G_; c = c_; }
    __device__ bool next(int i, Unit& u) const {
        const int ti = (NSEG == 2) ? (i >> 1) : i; u.seg = (NSEG == 2) ? (i & 1) : 0;
        const long L = (long)ti * G + c; if (L >= nwg) return false;
        int wgid = (int)L; { const int q = nwg / NXCD, r = nwg % NXCD, xcd = wgid % NXCD, off = wgid / NXCD; wgid = (xcd < r ? xcd * (q + 1) : r * (q + 1) + (xcd - r) * q) + off; }
        const int nig = WGM * nN, gid = wgid / nig, fm = gid * WGM, gsz = (nM - fm) < WGM ? (nM - fm) : WGM;
        u.pm = fm + ((wgid % nig) % gsz); u.pn = (wgid % nig) / gsz; return true;
    }
};

typedef f32x4 Acc[2][2][4][2];

template <class Epi, class Sched, int NSEG, bool ALIGN_EPI = true, bool AFTER_DRAIN = false>
__device__ __forceinline__ void gemm_phase(LAS unsigned char* lds, const Gemm g, const Sched& S, const Epi& E) {
    const int tid = threadIdx.x, wid = __builtin_amdgcn_readfirstlane(tid >> 6), lane = tid & 63, wr = wid >> 2, wc = wid & 3, fr = lane & 15, fq = lane >> 4;
    const int K = g.K, nt = K / BK;
    unsigned voffA[2], voffB[2];
#pragma unroll
    for (int i = 0; i < 2; ++i) { int R, C; stage_rc(tid * 16 + i * 8192, R, C); const int Rb = Epi::PERM ? ((R & ~31) + perm32(R & 31)) : R;
        voffA[i] = (unsigned)(R * K + C) * 2u; voffB[i] = (unsigned)(Rb * K + C) * 2u; }
    const size_t kstep = (size_t)(BK * 2);
    const size_t hstep = (size_t)HALF * K * 2;
    const size_t tstep = 2 * hstep;
    const unsigned ldsw = (unsigned)wid * 1024u;
    const int aoff = lds_byte(wr * 64 + fr, fq * 8), boff = lds_byte(wc * 32 + fr, fq * 8);
#define PG8_SA(b, h) (((b) * 2 + (h)) * HTB)
#define PG8_SB(b, h) ((4 + (b) * 2 + (h)) * HTB)
#define PG8_STAGE(bufoff, gbase, voff) do { _Pragma("unroll") for (int _i = 0; _i < 2; ++_i) \
        __builtin_amdgcn_global_load_lds((const unsigned*)((const char*)(gbase) + (voff)[_i]), (LAS unsigned*)(lds + (bufoff) + ldsw + _i * 8192), 16, 0, 0); } while (0)
#define PG8_LDA(dst, b, h) do { _Pragma("unroll") for (int m = 0; m < 4; ++m) _Pragma("unroll") for (int k = 0; k < 2; ++k) dst[m][k] = *(const LAS bf16x8*)(lds + PG8_SA(b, h) + aoff + m * 2048 + k * 1024); } while (0)
#define PG8_LDB(dst, b, h) do { _Pragma("unroll") for (int n = 0; n < 2; ++n) _Pragma("unroll") for (int k = 0; k < 2; ++k) dst[n][k] = *(const LAS bf16x8*)(lds + PG8_SB(b, h) + boff + n * 2048 + k * 1024); } while (0)
#define PG8_MMA(ai, bj, At, Bt) do { __builtin_amdgcn_s_setprio(1); _Pragma("unroll") for (int m = 0; m < 4; ++m) _Pragma("unroll") for (int n = 0; n < 2; ++n) _Pragma("unroll") for (int k = 0; k < 2; ++k) \
        acc[ai][bj][m][n] = __builtin_amdgcn_mfma_f32_16x16x32_bf16(Bt[n][k], At[m][k], acc[ai][bj][m][n], 0, 0, 0); __builtin_amdgcn_s_setprio(0); } while (0)
#define PG8_WAIT_V(n) asm volatile("s_waitcnt vmcnt(" #n ")" ::: "memory")
#define PG8_WAIT_L(n) asm volatile("s_waitcnt lgkmcnt(" #n ")" ::: "memory")
#define PG8_BAR __builtin_amdgcn_s_barrier()
#define PG8_SCHED __builtin_amdgcn_sched_barrier(0)
#define PG8_ABASE(u) ((const char*)(((NSEG == 2) && (u).seg) ? g.A2 : g.A) + (size_t)(u).pm * tstep)
#define PG8_BBASE(u) ((const char*)(((NSEG == 2) && (u).seg) ? g.Bt2 : g.Bt) + (size_t)(u).pn * tstep)
    Unit cur, nxt; int ui = 0;
    if (!S.next(0, cur)) return;
    f32x4 acc[2][2][4][2];
#pragma unroll
    for (int a = 0; a < 2; ++a)
#pragma unroll
        for (int b = 0; b < 2; ++b)
#pragma unroll
            for (int m = 0; m < 4; ++m)
#pragma unroll
                for (int n = 0; n < 2; ++n) acc[a][b][m][n] = (f32x4){0.f, 0.f, 0.f, 0.f};
    bf16x8 At[4][2], B0[2][2], B1[2][2];
    const char* cA = PG8_ABASE(cur); const char* cB = PG8_BBASE(cur);
    PG8_STAGE(PG8_SB(0, 0), cB, voffB); PG8_STAGE(PG8_SB(0, 1), cB + hstep, voffB); PG8_STAGE(PG8_SA(0, 0), cA, voffA); PG8_STAGE(PG8_SA(0, 1), cA + hstep, voffA);
    if (wr == 1) PG8_BAR;
    PG8_WAIT_V(2); PG8_BAR;
    PG8_STAGE(PG8_SB(1, 0), cB + kstep, voffB); PG8_STAGE(PG8_SA(1, 0), cA + kstep, voffA); PG8_STAGE(PG8_SB(1, 1), cB + hstep + kstep, voffB);
    PG8_WAIT_V(6); PG8_BAR;
    for (;;) {
        const bool has_next = S.next(ui + 1, nxt);
        const char* nA = has_next ? PG8_ABASE(nxt) : cA; const char* nB = has_next ? PG8_BBASE(nxt) : cB;
        for (int t = 0; t < nt; t += 2) {
            const bool last = (t == nt - 2);
            const char* a1 = cA + (size_t)(t + 1) * kstep;
            const char* a2 = last ? nA : cA + (size_t)(t + 2) * kstep; const char* b2 = last ? nB : cB + (size_t)(t + 2) * kstep;
            const char* a3 = a2 + kstep; const char* b3 = b2 + kstep;
            PG8_LDB(B0, 0, 0); PG8_LDB(B1, 0, 1); PG8_SCHED; PG8_LDA(At, 0, 0); PG8_STAGE(PG8_SA(1, 1), a1 + hstep, voffA);
            PG8_WAIT_V(8); PG8_WAIT_L(0); PG8_BAR; PG8_MMA(0, 0, At, B0); PG8_MMA(0, 1, At, B1); PG8_BAR; PG8_SCHED;
            PG8_LDA(At, 0, 1); PG8_STAGE(PG8_SB(0, 0), b2, voffB); PG8_STAGE(PG8_SB(0, 1), b2 + hstep, voffB); PG8_STAGE(PG8_SA(0, 0), a2, voffA);
            PG8_WAIT_V(8); PG8_WAIT_L(0); PG8_BAR; PG8_MMA(1, 0, At, B0); PG8_MMA(1, 1, At, B1); PG8_BAR; PG8_SCHED;
            PG8_LDB(B0, 1, 0); PG8_LDB(B1, 1, 1); PG8_SCHED; PG8_LDA(At, 1, 0); PG8_STAGE(PG8_SA(0, 1), a2 + hstep, voffA);
            PG8_WAIT_V(8); PG8_WAIT_L(0); PG8_BAR; PG8_MMA(0, 0, At, B0); PG8_MMA(0, 1, At, B1); PG8_BAR; PG8_SCHED;
            PG8_LDA(At, 1, 1); PG8_STAGE(PG8_SB(1, 0), b3, voffB); PG8_STAGE(PG8_SB(1, 1), b3 + hstep, voffB); PG8_STAGE(PG8_SA(1, 0), a3, voffA);
            PG8_WAIT_V(8); PG8_WAIT_L(0); PG8_BAR; PG8_MMA(1, 0, At, B0); PG8_MMA(1, 1, At, B1); PG8_BAR; PG8_SCHED;
        }
        if constexpr (ALIGN_EPI) { if (wr == 0) PG8_BAR; }
        const bool midseg = (NSEG == 2) && (cur.seg == 0);
        if (midseg) E.mid(acc, cur, wr, wc, fr, fq); else if constexpr (!AFTER_DRAIN) E(acc, cur, wr, wc, fr, fq);
        if (!has_next) break;
        if (!midseg) {
#pragma unroll
            for (int a = 0; a < 2; ++a)
#pragma unroll
                for (int b = 0; b < 2; ++b)
#pragma unroll
                    for (int m = 0; m < 4; ++m)
#pragma unroll
                        for (int n = 0; n < 2; ++n) acc[a][b][m][n] = (f32x4){0.f, 0.f, 0.f, 0.f};
        }
        cur = nxt; cA = nA; cB = nB; ++ui;
        if constexpr (ALIGN_EPI) { if (wr == 1) PG8_BAR; }
    }
    PG8_WAIT_V(0);
    if constexpr (!ALIGN_EPI) { if (wr == 0) PG8_BAR; }
    PG8_BAR;
    if constexpr (AFTER_DRAIN) E.fused(acc, cur, wr, wc, fr, fq, lds, wid, lane);
#undef PG8_SA
#undef PG8_SB
#undef PG8_STAGE
#undef PG8_LDA
#undef PG8_LDB
#undef PG8_MMA
#undef PG8_WAIT_V
#undef PG8_WAIT_L
#undef PG8_BAR
#undef PG8_SCHED
#undef PG8_ABASE
#undef PG8_BBASE
}

__device__ __forceinline__ u32x4 pack8(f32x4 v0, f32x4 v1) { u32x4 w; w.x = cvt_pk_bf16(v0[0], v0[1]); w.y = cvt_pk_bf16(v0[2], v0[3]); w.z = cvt_pk_bf16(v1[0], v1[1]); w.w = cvt_pk_bf16(v1[2], v1[3]); return w; }

struct EpiProj {
    static constexpr bool PERM = true;
    bf16_t *Q, *K, *V, *Z, *P1, *P2, *R, *S2;
    __device__ __forceinline__ void mid(Acc&, const Unit&, int, int, int, int) const {}
    __device__ __forceinline__ void operator()(const Acc& acc, const Unit& u, int wr, int wc, int fr, int fq) const {
        const int pm = u.pm, pn = u.pn; const int b = pm >> 4;
        const int rloc = wr * 64 + fr, cl = wc * 32 + 8 * fq;
        if (pn < 32) {
            const int kind = pn >> 3, colt = (pn & 7) * 256 + cl;
            if (kind == 0 || kind == 3) {
                bf16_t* base = (kind == 0 ? Q : Z) + (size_t)(pm * 256 + rloc) * DM + colt;
#pragma unroll
                for (int ai = 0; ai < 2; ++ai)
#pragma unroll
                    for (int m = 0; m < 4; ++m)
#pragma unroll
                        for (int bj = 0; bj < 2; ++bj) { f32x4 v0 = acc[ai][bj][m][0], v1 = acc[ai][bj][m][1];
                            if (kind == 0) { v0 = v0 * QSCALE; v1 = v1 * QSCALE; }
                            else {
#pragma unroll
                                for (int j = 0; j < 4; ++j) { v0[j] = siluf_(v0[j]); v1[j] = siluf_(v1[j]); } }
                            *(u32x4*)(base + (size_t)(ai * 128 + m * 16) * DM + bj * 128) = pack8(v0, v1); }
            } else {
                bf16_t* base = (kind == 1 ? K : V) + ((size_t)(b * NH + 2 * (pn & 7)) * KVROWS + 64 + (pm & 15) * 256 + rloc) * HD + cl;
#pragma unroll
                for (int ai = 0; ai < 2; ++ai)
#pragma unroll
                    for (int m = 0; m < 4; ++m)
#pragma unroll
                        for (int bj = 0; bj < 2; ++bj) *(u32x4*)(base + (size_t)bj * KVROWS * HD + (size_t)(ai * 128 + m * 16) * HD) = pack8(acc[ai][bj][m][0], acc[ai][bj][m][1]);
            }
        } else {
            const int kind = (pn - 32) >> 4, p = (pn - 32) & 15, col = p * 128 + cl;
            if (kind == 0) {
                bf16_t* base = P1 + (size_t)(pm * 256 + 2 + 2 * b + rloc) * DM + col;
#pragma unroll
                for (int ai = 0; ai < 2; ++ai)
#pragma unroll
                    for (int m = 0; m < 4; ++m) __builtin_nontemporal_store(pack8(acc[ai][0][m][0] * acc[ai][1][m][0], acc[ai][0][m][1] * acc[ai][1][m][1]), (u32x4*)(base + (size_t)(ai * 128 + m * 16) * DM));
            } else if (kind == 1) {
                bf16_t* base = P2 + (size_t)(pm * 256 + rloc) * DM + col;
#pragma unroll
                for (int ai = 0; ai < 2; ++ai)
#pragma unroll
                    for (int m = 0; m < 4; ++m) { f32x4 v0, v1;
#pragma unroll
                        for (int j = 0; j < 4; ++j) { v0[j] = acc[ai][0][m][0][j] * siluf_(acc[ai][1][m][0][j]); v1[j] = acc[ai][0][m][1][j] * siluf_(acc[ai][1][m][1][j]); }
                        __builtin_nontemporal_store(pack8(v0, v1), (u32x4*)(base + (size_t)(ai * 128 + m * 16) * DM)); }
            } else {
                const size_t o0 = (size_t)(pm * 256 + rloc) * DM + col;
#pragma unroll
                for (int ai = 0; ai < 2; ++ai)
#pragma unroll
                    for (int m = 0; m < 4; ++m) { f32x4 r0, r1, s0, s1;
#pragma unroll
                        for (int j = 0; j < 4; ++j) { const float e1a = 1.0f + __expf(-acc[ai][0][m][0][j]), e2a = 1.0f + __expf(-acc[ai][1][m][0][j]);
                            const float e1b = 1.0f + __expf(-acc[ai][0][m][1][j]), e2b = 1.0f + __expf(-acc[ai][1][m][1][j]);
                            s0[j] = __builtin_amdgcn_rcpf(e2a); s1[j] = __builtin_amdgcn_rcpf(e2b); r0[j] = e2a * __builtin_amdgcn_rcpf(e1a); r1[j] = e2b * __builtin_amdgcn_rcpf(e1b); }
                        const size_t o = o0 + (size_t)(ai * 128 + m * 16) * DM;
                        __builtin_nontemporal_store(pack8(r0, r1), (u32x4*)(R + o)); __builtin_nontemporal_store(pack8(s0, s1), (u32x4*)(S2 + o)); }
            }
        }
    }
};

struct EpiMerge {
    static constexpr bool PERM = true;
    const bf16_t *R, *S2; bf16_t* MG;
    __device__ __forceinline__ void mid(Acc& acc, const Unit& u, int wr, int wc, int fr, int fq) const {
        const bf16_t* base = R + (size_t)(u.pm * 256 + wr * 64 + fr) * DM + u.pn * 256 + wc * 32 + 8 * fq;
#pragma unroll
        for (int ai = 0; ai < 2; ++ai)
#pragma unroll
            for (int m = 0; m < 4; ++m)
#pragma unroll
                for (int bj = 0; bj < 2; ++bj) { const u32x4 w = __builtin_nontemporal_load((const u32x4*)(base + (size_t)(ai * 128 + m * 16) * DM + bj * 128));
                    acc[ai][bj][m][0] *= (f32x4){bf_lo(w.x), bf_hi(w.x), bf_lo(w.y), bf_hi(w.y)}; acc[ai][bj][m][1] *= (f32x4){bf_lo(w.z), bf_hi(w.z), bf_lo(w.w), bf_hi(w.w)}; }
    }
    __device__ __forceinline__ void operator()(const Acc& acc, const Unit& u, int wr, int wc, int fr, int fq) const {
        const size_t o0 = (size_t)(u.pm * 256 + wr * 64 + fr) * DM + u.pn * 256 + wc * 32 + 8 * fq;
#pragma unroll
        for (int ai = 0; ai < 2; ++ai)
#pragma unroll
            for (int m = 0; m < 4; ++m)
#pragma unroll
                for (int bj = 0; bj < 2; ++bj) { const size_t o = o0 + (size_t)(ai * 128 + m * 16) * DM + bj * 128; const u32x4 w = __builtin_nontemporal_load((const u32x4*)(S2 + o));
                    const f32x4 v0 = acc[ai][bj][m][0] * (f32x4){bf_lo(w.x), bf_hi(w.x), bf_lo(w.y), bf_hi(w.y)}, v1 = acc[ai][bj][m][1] * (f32x4){bf_lo(w.z), bf_hi(w.z), bf_lo(w.w), bf_hi(w.w)};
                    *(u32x4*)(MG + o) = pack8(v0, v1); }
    }
};

struct EpiOut {
    static constexpr bool PERM = false;
    const float* x; float* out; float* SS;
    __device__ __forceinline__ void mid(Acc&, const Unit&, int, int, int, int) const {}
    __device__ __forceinline__ void operator()(const Acc& acc, const Unit& u, int wr, int wc, int fr, int fq) const {
        const size_t o0 = (size_t)(u.pm * 256 + wr * 64 + fr) * DM + u.pn * 256 + wc * 32 + 4 * fq;
#pragma unroll
        for (int ai = 0; ai < 2; ++ai)
#pragma unroll
            for (int m = 0; m < 4; ++m) { float s = 0.f; const size_t o = o0 + (size_t)(ai * 128 + m * 16) * DM;
#pragma unroll
                for (int bj = 0; bj < 2; ++bj)
#pragma unroll
                    for (int n = 0; n < 2; ++n) { const f32x4 y = *(const f32x4*)(x + o + bj * 128 + n * 16) + acc[ai][bj][m][n];
                        s += (y[0] * y[0] + y[1] * y[1]) + (y[2] * y[2] + y[3] * y[3]); *(f32x4*)(out + o + bj * 128 + n * 16) = y; }
                s += __shfl_xor(s, 16); s += __shfl_xor(s, 32);
                if (fq == 0) SS[(size_t)(u.pm * 256 + wr * 64 + fr + ai * 128 + m * 16) * 32 + u.pn * 4 + wc] = s; }
    }
};
struct EpiOutNorm {
    static constexpr bool PERM = false;
    const float* x; float* out; const float* gain; float* xbuf; unsigned* cnt;
    __device__ __forceinline__ void mid(Acc&, const Unit&, int, int, int, int) const {}
    __device__ __forceinline__ void operator()(const Acc&, const Unit&, int, int, int, int) const {}
    __device__ __forceinline__ void fused(Acc& acc, const Unit& u, int wr, int wc, int fr, int fq, LAS unsigned char* lds, int wid, int lane) const {
        LAS float* P = (LAS float*)lds;
        LAS float* S = (LAS float*)(lds + 8192);
        const size_t o0 = (size_t)(u.pm * 256 + wr * 64 + fr) * DM + u.pn * 256 + wc * 32 + 4 * fq;
#pragma unroll
        for (int ai = 0; ai < 2; ++ai)
#pragma unroll
            for (int m = 0; m < 4; ++m) { float s = 0.f; const size_t o = o0 + (size_t)(ai * 128 + m * 16) * DM;
#pragma unroll
                for (int bj = 0; bj < 2; ++bj)
#pragma unroll
                    for (int n = 0; n < 2; ++n) { const f32x4 y = __builtin_nontemporal_load((const f32x4*)(x + o + bj * 128 + n * 16)) + acc[ai][bj][m][n]; acc[ai][bj][m][n] = y;
                        s += (y[0] * y[0] + y[1] * y[1]) + (y[2] * y[2] + y[3] * y[3]); }
                s += __shfl_xor(s, 16); s += __shfl_xor(s, 32);
                if (fq == 0) P[(ai * 128 + wr * 64 + m * 16 + fr) * 4 + wc] = s; }
        asm volatile("s_waitcnt lgkmcnt(0)" ::: "memory"); __builtin_amdgcn_s_barrier(); asm volatile("" ::: "memory");
        const int row = wid * 32 + (lane & 31);
        if (lane < 32) { const float t = (P[row * 4 + 0] + P[row * 4 + 1]) + (P[row * 4 + 2] + P[row * 4 + 3]);
            __hip_atomic_store(xbuf + (size_t)(u.pm * 256 + row) * 8 + u.pn, t, __ATOMIC_RELAXED, __HIP_MEMORY_SCOPE_AGENT); }
        asm volatile("s_waitcnt vmcnt(0)" ::: "memory");
        if (lane == 0) __hip_atomic_fetch_add(cnt + 64 * u.pm, 1u, __ATOMIC_RELAXED, __HIP_MEMORY_SCOPE_AGENT);
        if (wid == 0) {
            while ((unsigned)__builtin_amdgcn_readfirstlane(__hip_atomic_load(cnt + 64 * u.pm, __ATOMIC_RELAXED, __HIP_MEMORY_SCOPE_AGENT)) < 64u) __builtin_amdgcn_s_sleep(2);
            __builtin_amdgcn_fence(__ATOMIC_ACQUIRE, "agent");
        }
        asm volatile("s_waitcnt vmcnt(0) lgkmcnt(0)" ::: "memory"); __builtin_amdgcn_s_barrier(); asm volatile("" ::: "memory");
        if (lane < 32) { const float* slot = xbuf + (size_t)(u.pm * 256 + row) * 8; float t = 0.f;
#pragma unroll
            for (int k = 0; k < 8; ++k) t += __hip_atomic_load(slot + k, __ATOMIC_RELAXED, __HIP_MEMORY_SCOPE_AGENT);
            S[row] = 1.0f / sqrtf(t * (1.f / DM) + EPS); }
        asm volatile("s_waitcnt lgkmcnt(0)" ::: "memory"); __builtin_amdgcn_s_barrier(); asm volatile("" ::: "memory");
        const int c0 = u.pn * 256 + wc * 32 + 4 * fq;
#pragma unroll
        for (int bj = 0; bj < 2; ++bj)
#pragma unroll
            for (int n = 0; n < 2; ++n) { const f32x4 g = *(const f32x4*)(gain + c0 + bj * 128 + n * 16);
#pragma unroll
                for (int ai = 0; ai < 2; ++ai)
#pragma unroll
                    for (int m = 0; m < 4; ++m) { const int r = ai * 128 + wr * 64 + m * 16 + fr;
                        __builtin_nontemporal_store(acc[ai][bj][m][n] * S[r] * g, (f32x4*)(out + (size_t)(u.pm * 256 + r) * DM + c0 + bj * 128 + n * 16)); } }
    }
};
}

namespace att {
constexpr int D = 128, LD = DM, NW = 8, QBLK = 32, KVBLK = 64, QB = 256;
constexpr int SHM_V = KVBLK * D * 2, SHM_K = KVBLK * D * 2;
constexpr int NSLOT = 3, SLOT = SHM_V, OFF_K = NSLOT * SHM_V;
constexpr int OFF_WS = NSLOT * (SHM_V + SHM_K), OFF_C = OFF_WS + NW * 64 * 4, OFF_RED = OFF_C + KVROWS * 4, LDS_BYTES = OFF_RED + 64;
constexpr float THR2 = 11.5f;
#define KSWZ(row, colB) ((row) * 256 + ((colB) ^ (((row) & 7) << 4)))
#define SBAR() __builtin_amdgcn_sched_barrier(0)
__device__ __forceinline__ int v_st(int k, int c) { const int kk = (k & ~0xC) | ((k & 4) << 1) | ((k & 8) >> 1); return ((kk >> 3) * 4 + (c >> 5)) * 512 + ((kk & 7) * 32 + (c & 31)) * 2; }
__device__ __forceinline__ int v_rd_base(int lane) { return ((lane & 3) << 3) | (((lane >> 2) & 3) << 6) | (((lane >> 4) & 1) << 5) | (((lane >> 5) & 1) << 8); }
constexpr int v_rd_off(int d0, int ks, int half) { return d0 * 512 + ks * 4096 + half * 2048; }
__device__ __forceinline__ int crow(int r, int hi) { return (r & 3) + 8 * (r >> 2) + 4 * hi; }
__device__ __forceinline__ bf16x8 load8(const bf16_t* p) { return *reinterpret_cast<const bf16x8*>(p); }

__device__ __forceinline__ void mask_tile(f32x16& p0, f32x16& p1, int dq) {
    const float NEG = -__builtin_inff();
#pragma unroll
    for (int r = 0; r < 16; ++r) { const int c = (r & 3) + 8 * (r >> 2); if (dq - c < 0) p0[r] = NEG; if (dq - c - 32 < 0) p1[r] = NEG; }
}
__device__ __forceinline__ void mask_meta(f32x16& p0, f32x16& p1) {
    const float NEG = -__builtin_inff();
#pragma unroll
    for (int r = 0; r < 16; ++r) { p0[r] = NEG; if (r < 8) p1[r] = NEG; }
}
__device__ __forceinline__ void partialSM(f32x16& p0, f32x16& p1, float& m_reg, float& mn, float& alpha) {
    float pmax = p0[0];
#pragma unroll
    for (int r = 1; r < 16; ++r) pmax = fmaxf(pmax, p0[r]);
#pragma unroll
    for (int r = 0; r < 16; ++r) pmax = fmaxf(pmax, p1[r]);
    { auto rr = __builtin_amdgcn_permlane32_swap(__float_as_uint(pmax), __float_as_uint(pmax), false, false);
      pmax = fmaxf(__uint_as_float(rr[0]), __uint_as_float(rr[1])); }
    if (__builtin_expect(__all((pmax - m_reg) <= THR2), 1)) { mn = m_reg; alpha = 1.f; }
    else { mn = fmaxf(m_reg, pmax); alpha = __builtin_amdgcn_exp2f(m_reg - mn); m_reg = mn; }
#pragma unroll
    for (int r = 0; r < 16; ++r) p0[r] = p0[r] - mn;
#pragma unroll
    for (int r = 0; r < 16; ++r) p1[r] = p1[r] - mn;
#pragma unroll
    for (int r = 0; r < 16; ++r) p0[r] = __builtin_amdgcn_exp2f(p0[r]);
}
__device__ __forceinline__ void finishSM(f32x16& p0, f32x16& p1, float alpha, float& l_reg, bf16x8& pa0, bf16x8& pa1, bf16x8& pa2, bf16x8& pa3) {
#pragma unroll
    for (int r = 0; r < 16; ++r) p1[r] = __builtin_amdgcn_exp2f(p1[r]);
    float ps = 0;
#pragma unroll
    for (int r = 0; r < 16; ++r) ps += p0[r];
#pragma unroll
    for (int r = 0; r < 16; ++r) ps += p1[r];
    { auto rr = __builtin_amdgcn_permlane32_swap(__float_as_uint(ps), __float_as_uint(ps), false, false);
      ps = __uint_as_float(rr[0]) + __uint_as_float(rr[1]); }
    l_reg = l_reg * alpha + ps;
#define PK4(P, B_, OUT) do { unsigned a0 = cvt_pk_bf16(P[B_+0], P[B_+1]), a1 = cvt_pk_bf16(P[B_+2], P[B_+3]);                          \
        unsigned b0 = cvt_pk_bf16(P[B_+4], P[B_+5]), b1 = cvt_pk_bf16(P[B_+6], P[B_+7]);                                             \
        auto r0 = __builtin_amdgcn_permlane32_swap(a0, b0, false, false); auto r1 = __builtin_amdgcn_permlane32_swap(a1, b1, false, false); \
        u32x4 w = {r0[0], r1[0], r0[1], r1[1]}; OUT = *reinterpret_cast<bf16x8*>(&w); } while (0)
    PK4(p0, 0, pa0); PK4(p0, 8, pa1); PK4(p1, 0, pa2); PK4(p1, 8, pa3);
#undef PK4
}
__device__ __forceinline__ void qkt(f32x16& p0, f32x16& p1, const char* Kslot, int r32, int hi, const bf16x8* qr, const LAS f32x4* cp) {
#pragma unroll
    for (int g = 0; g < 4; ++g) { const f32x4 c0 = cp[2 * g], c1 = cp[8 + 2 * g];
#pragma unroll
        for (int j = 0; j < 4; ++j) { p0[4 * g + j] = c0[j]; p1[4 * g + j] = c1[j]; } }
    const char* kb[4];
#pragma unroll
    for (int dd = 0; dd < 4; ++dd) kb[dd] = Kslot + KSWZ(r32, (dd * 16 + hi * 8) * 2);
#pragma unroll
    for (int d0 = 0; d0 < 8; ++d0) { const char* a = kb[d0 & 3] + (d0 >> 2) * 128;
        bf16x8 b0 = *reinterpret_cast<const bf16x8*>(a);
        bf16x8 b1 = *reinterpret_cast<const bf16x8*>(a + 32 * 256);
        p0 = __builtin_amdgcn_mfma_f32_32x32x16_bf16(b0, qr[d0], p0, 0, 0, 0);
        p1 = __builtin_amdgcn_mfma_f32_32x32x16_bf16(b1, qr[d0], p1, 0, 0, 0); }
}
__device__ __forceinline__ void pv_tile(f32x16* o, int vb0, bf16x8 pa0, bf16x8 pa1, bf16x8 pa2, bf16x8 pa3) {
#define TRRD(dst, off) asm volatile("ds_read_b64_tr_b16 %0, %1 offset:%2" : "=&v"(dst) : "v"(vb0), "i"(off) : "memory")
#define PV_RD(d0, kh, X) do { constexpr int b_ = v_rd_off(d0, 2 * (kh), 0); TRRD(X##l0, b_); TRRD(X##h0, b_ + 2048); TRRD(X##l1, b_ + 4096); TRRD(X##h1, b_ + 6144); } while (0)
#define PV_MM(d0, X, PA, PB) do { \
        o[d0] = __builtin_amdgcn_mfma_f32_32x32x16_bf16(PA, (bf16x8){X##l0[0], X##l0[1], X##l0[2], X##l0[3], X##h0[0], X##h0[1], X##h0[2], X##h0[3]}, o[d0], 0, 0, 0);   \
        o[d0] = __builtin_amdgcn_mfma_f32_32x32x16_bf16(PB, (bf16x8){X##l1[0], X##l1[1], X##l1[2], X##l1[3], X##h1[0], X##h1[1], X##h1[2], X##h1[3]}, o[d0], 0, 0, 0); } while (0)
#define PV_W4() do { asm volatile("s_waitcnt lgkmcnt(4)" ::: "memory"); SBAR(); } while (0)
#define PV_W0() do { asm volatile("s_waitcnt lgkmcnt(0)" ::: "memory"); SBAR(); } while (0)
    s16x4 al0, al1, ah0, ah1, bl0, bl1, bh0, bh1;
    PV_RD(0, 0, a);
    PV_RD(0, 1, b); PV_W4(); PV_MM(0, a, pa0, pa1); SBAR();
    PV_RD(1, 0, a); PV_W4(); PV_MM(0, b, pa2, pa3); SBAR();
    PV_RD(1, 1, b); PV_W4(); PV_MM(1, a, pa0, pa1); SBAR();
    PV_RD(2, 0, a); PV_W4(); PV_MM(1, b, pa2, pa3); SBAR();
    PV_RD(2, 1, b); PV_W4(); PV_MM(2, a, pa0, pa1); SBAR();
    PV_RD(3, 0, a); PV_W4(); PV_MM(2, b, pa2, pa3); SBAR();
    PV_RD(3, 1, b); PV_W4(); PV_MM(3, a, pa0, pa1); SBAR();
    PV_W0(); PV_MM(3, b, pa2, pa3);
#undef PV_RD
#undef PV_MM
#undef PV_W4
#undef PV_W0
#undef TRRD
}

struct BlockRef { const bf16_t* Q; const bf16_t* K; const bf16_t* V; const bf16_t* Z; bf16_t* O; int P0; };
struct Seam { bf16x8 qr[8]; };
#define WAITV_BAR(N) asm volatile("s_waitcnt vmcnt(" #N ") lgkmcnt(0)\n\ts_barrier" ::: "memory")
struct DmaOff { unsigned k[2], v[2]; };
__device__ __forceinline__ DmaOff dma_offsets(int wid, int lane) {
    DmaOff d;
#pragma unroll
    for (int i = 0; i < 2; ++i) { const int pc = wid * 2 + i, q = pc * 64 + lane;
        const int row = q >> 4, j = (q & 15) ^ (row & 7); d.k[i] = (unsigned)(row * 256 + j * 16);
        const int s = q >> 5, w = q & 31, kk = (s >> 2) * 8 + (w >> 2), c = (s & 3) * 32 + (w & 3) * 8, k = (kk & ~0xC) | ((kk & 4) << 1) | ((kk & 8) >> 1);
        d.v[i] = (unsigned)(k * 256 + c * 2); }
    return d;
}
#define DMA_K(t, slot) do { _Pragma("unroll") for (int i_ = 0; i_ < 2; ++i_) __builtin_amdgcn_global_load_lds((const unsigned*)((const char*)Kh + (size_t)(t) * (KVBLK * D * 2) + dof.k[i_]), \
        (LAS unsigned*)((LAS unsigned char*)lds3 + OFF_K + (slot) + (wid * 2 + i_) * 1024), 16, 0, 0); } while (0)
#define DMA_V(t, slot) do { _Pragma("unroll") for (int i_ = 0; i_ < 2; ++i_) __builtin_amdgcn_global_load_lds((const unsigned*)((const char*)Vh + (size_t)(t) * (KVBLK * D * 2) + dof.v[i_]), \
        (LAS unsigned*)((LAS unsigned char*)lds3 + (slot) + (wid * 2 + i_) * 1024), 16, 0, 0); } while (0)
__device__ __forceinline__ void fox_prime(const BlockRef& cur, char* lds, Seam& S, const int tid) {
    const int wid = __builtin_amdgcn_readfirstlane(tid >> 6), lane = tid & 63, r32 = lane & 31, hi = lane >> 5;
    LAS unsigned char* lds3 = (LAS unsigned char*)lds; const DmaOff dof = dma_offsets(wid, lane);
    const bf16_t* Kh = cur.K; const bf16_t* Vh = cur.V;
#pragma unroll
    for (int d0 = 0; d0 < 8; ++d0) S.qr[d0] = load8(cur.Q + (size_t)(wid * QBLK + r32) * LD + d0 * 16 + hi * 8);
    SBAR(); DMA_K(0, 0); DMA_K(1, SLOT); DMA_V(0, 0); SBAR();
    WAITV_BAR(0);
}
__device__ __forceinline__ void fox_block(const BlockRef& cur, const BlockRef& nxt, char* lds, Seam& S, const int tid) {
    const int wid = __builtin_amdgcn_readfirstlane(tid >> 6), lane = tid & 63, r32 = lane & 31, hi = lane >> 5;
    const int NT = cur.P0 / KVBLK + 4;
    const int qlo = cur.P0 + wid * QBLK, qm = qlo + r32 - 4 * hi;
    char* V_lds = lds; char* K_lds = lds + OFF_K; LAS unsigned char* lds3 = (LAS unsigned char*)lds;
    float* ws = (float*)(lds + OFF_WS) + wid * 64; float* li_l = ws, * al_l = ws + 32;
    const LAS float* ctab = (const LAS float*)(LAS char*)(lds + OFF_C);
    float m_reg = -1e30f, l_reg = 0; f32x16 o[4] = {};
    const DmaOff dof = dma_offsets(wid, lane);
    const int vb0 = (int)(uintptr_t)V_lds + v_rd_base(lane);
    const bf16_t* Kh = cur.K; const bf16_t* Vh = cur.V;
#define RESC(a) do { if (__any((a) < 1.f)) { if (hi == 0) al_l[r32] = (a); asm volatile("s_waitcnt lgkmcnt(0)" ::: "memory");              \
                     for (int d_ = 0; d_ < 4; ++d_) for (int r = 0; r < 16; ++r) o[d_][r] *= al_l[crow(r, hi)]; } } while (0)
#define MASKT(P0_, P1_, t) do { const int kb_ = (t) * KVBLK; if (kb_ + KVBLK - 1 > qlo) mask_tile(P0_, P1_, qm - kb_); } while (0)
#define CTP(t) ((const LAS f32x4*)(ctab + (t) * KVBLK + 4 * hi))
#define ROT() do { s_prev = s_cur; s_cur = s_next; s_next = s_nn; s_nn = (s_nn == (NSLOT - 1) * SLOT) ? 0 : s_nn + SLOT; } while (0)
#define ENDW(t) do { if ((t) + 2 < NT) { WAITV_BAR(4); } else if ((t) + 1 < NT) { WAITV_BAR(2); } else { WAITV_BAR(0); } } while (0)
    f32x16 pA0, pA1, pB0, pB1; float mnA, mnB, alA, alB; bf16x8 pa0, pa1, pa2, pa3;
    int s_prev = 0, s_cur = 0, s_next = SLOT, s_nn = 2 * SLOT;
    SBAR(); DMA_K(2, s_nn); DMA_V(1, s_next); SBAR();
    qkt(pA0, pA1, K_lds + s_cur, r32, hi, S.qr, CTP(0));
    mask_meta(pA0, pA1); partialSM(pA0, pA1, m_reg, mnA, alA);
    SBAR(); WAITV_BAR(4);
    ROT();
#define STEP(PX0, PX1, mnX, alX, PY0, PY1, alY, t) do {                                                                       \
        SBAR(); if ((t) + 2 < NT) { DMA_K((t) + 2, s_nn); } if ((t) + 1 < NT) { DMA_V((t) + 1, s_next); }                     \
        SBAR(); qkt(PX0, PX1, K_lds + s_cur, r32, hi, S.qr, CTP(t));                                                          \
        finishSM(PY0, PY1, alY, l_reg, pa0, pa1, pa2, pa3); SBAR();                                                           \
        pv_tile(o, vb0 + s_prev, pa0, pa1, pa2, pa3); MASKT(PX0, PX1, (t)); partialSM(PX0, PX1, m_reg, mnX, alX);             \
        RESC(alX);                                                                                                            \
        SBAR(); ENDW(t);                                                                                                      \
        ROT(); } while (0)
    for (int t = 1; t + 1 < NT; t += 2) {
        STEP(pB0, pB1, mnB, alB, pA0, pA1, alA, t);
        STEP(pA0, pA1, mnA, alA, pB0, pB1, alB, t + 1);
    }
    finishSM(pA0, pA1, alA, l_reg, pa0, pa1, pa2, pa3); SBAR();
    pv_tile(o, vb0 + s_prev, pa0, pa1, pa2, pa3);
    SBAR(); WAITV_BAR(0);
    { const bf16_t* Kh = nxt.K; const bf16_t* Vh = nxt.V;
#pragma unroll
      for (int d0 = 0; d0 < 8; ++d0) S.qr[d0] = load8(nxt.Q + (size_t)(wid * QBLK + r32) * LD + d0 * 16 + hi * 8);
      SBAR(); DMA_K(0, 0); DMA_K(1, SLOT); DMA_V(0, 0); SBAR(); }
    if (hi == 0) li_l[r32] = l_reg; asm volatile("s_waitcnt lgkmcnt(0)" ::: "memory");
    float rli[16];
#pragma unroll
    for (int r = 0; r < 16; ++r) rli[r] = __builtin_amdgcn_rcpf(li_l[crow(r, hi)]);
    typedef __attribute__((address_space(1))) bf16_t gbf16; typedef __attribute__((address_space(1))) u32x4 gu32x4;
    LAS float* stg = (LAS float*)(lds3 + SLOT + wid * 4096);
    const int er = lane >> 2, eq = lane & 3;
    gbf16* obase = (gbf16*)(cur.O + (size_t)(wid * QBLK + er) * LD + 8 * eq); const gbf16* zbase = (const gbf16*)(cur.Z + (size_t)(wid * QBLK + er) * LD + 8 * eq);
#pragma unroll
    for (int d0 = 0; d0 < 4; ++d0) {
#pragma unroll
        for (int r = 0; r < 16; ++r) stg[crow(r, hi) * 32 + r32] = o[d0][r] * rli[r];
        asm volatile("s_waitcnt lgkmcnt(0)" ::: "memory");
        gbf16* op = obase; const gbf16* zp = zbase;
#pragma unroll
        for (int i = 0; i < 2; ++i) {
            asm volatile("" : "+v"(op), "+v"(zp));
            const f32x4 v0 = *(const LAS f32x4*)(stg + (er + 16 * i) * 32 + 8 * eq), v1 = *(const LAS f32x4*)(stg + (er + 16 * i) * 32 + 8 * eq + 4);
            const u32x4 z = __builtin_nontemporal_load((const gu32x4*)(zp + d0 * 32));
            u32x4 w; w.x = cvt_pk_bf16(v0.x * bf_lo(z.x), v0.y * bf_hi(z.x)); w.y = cvt_pk_bf16(v0.z * bf_lo(z.y), v0.w * bf_hi(z.y));
            w.z = cvt_pk_bf16(v1.x * bf_lo(z.z), v1.y * bf_hi(z.z)); w.w = cvt_pk_bf16(v1.z * bf_lo(z.w), v1.w * bf_hi(z.w));
            *(gu32x4*)(op + d0 * 32) = w;
            op += 16 * LD; zp += 16 * LD; }
        asm volatile("s_waitcnt lgkmcnt(0)" ::: "memory"); }
    WAITV_BAR(0);
#undef RESC
#undef MASKT
#undef CTP
#undef ROT
#undef ENDW
#undef STEP
}
#undef DMA_K
#undef DMA_V
#undef WAITV_BAR
#undef ROWP
#undef VMW
#undef VMWN
#undef SLOAD_H
#undef SWRITE_H
__device__ __forceinline__ void build_ctab(char* lds, const float* LFbh, const int tid) {
    const int lane = tid & 63, wid = tid >> 6;
    float* ctab = (float*)(lds + OFF_C); float* red = (float*)(lds + OFF_RED);
    constexpr int PER = 9; const int e0 = tid * PER;
    float v[PER]; float s = 0.f;
#pragma unroll
    for (int i = 0; i < PER; ++i) { const int kk = e0 + i; float x = 0.f; if (kk >= 48 && kk < KVROWS) x = LFbh[kk]; s += x; v[i] = s; }
    float incl = s;
#pragma unroll
    for (int off = 1; off < 64; off <<= 1) { const float t = __shfl_up(incl, off); if (lane >= off) incl += t; }
    if (lane == 63) red[wid] = incl;
    __syncthreads();
    float base = incl - s;
    for (int w = 0; w < wid; ++w) base += red[w];
#pragma unroll
    for (int i = 0; i < PER; ++i) { const int kk = e0 + i; if (kk < KVROWS) ctab[kk] = -(base + v[i]); }
    __syncthreads();
}
struct Tensors { const bf16_t* Q; const bf16_t* K; const bf16_t* V; const bf16_t* Z; bf16_t* O; const float* LF; };
__device__ __forceinline__ BlockRef mkref(const Tensors& T, int b, int h, int qb) {
    BlockRef r; const size_t qo = (size_t)(b * SEQ + qb * QB) * LD + h * D, ko = (size_t)(b * NH + h) * KVROWS * D;
    r.Q = T.Q + qo; r.Z = T.Z + qo; r.O = T.O + qo; r.K = T.K + ko; r.V = T.V + ko; r.P0 = 64 + qb * QB; return r;
}
__device__ __forceinline__ void attn_phase(char* lds, const Tensors& T, int vcu, int G) {
    for (int L = vcu; L < NB * NH * 8; L += G) {
        const int bh = L >> 3, x = L & 7, b = bh >> 4, h = bh & 15;
        int tid = threadIdx.x; asm volatile("" : "+v"(tid));
        build_ctab(lds, T.LF + (size_t)(b * NH + h) * KVROWS, tid);
        const BlockRef r0 = mkref(T, b, h, 15 - x), r1 = mkref(T, b, h, x);
        Seam S;
        fox_prime(r0, lds, S, tid);
        fox_block(r0, r1, lds, S, tid);
        fox_block(r1, r1, lds, S, tid);
    }
}
#undef SBAR
#undef KSWZ
}

constexpr int NWAVES = 8, NTHREADS = 512;
constexpr int LDS_BYTES = 147456;
static_assert(att::LDS_BYTES <= 131072 && pg8::STAGE_BYTES <= 131072, "LDS map");

struct Args { const float* in[10]; float* out; unsigned char* ws; int ph_lo, ph_hi; };

__device__ __forceinline__ unsigned f2bf(float f) { unsigned u = __builtin_bit_cast(unsigned, f); return (u + 0x7fffu + ((u >> 16) & 1u)) >> 16; }
__device__ __forceinline__ unsigned pk2(float lo, float hi) { return cvt_pk_bf16(lo, hi); }
__device__ __forceinline__ float wave_sum(float v) {
#pragma unroll
    for (int o = 1; o < 64; o <<= 1) v += __shfl_xor(v, o);
    return v;
}
__device__ __forceinline__ int src_col_of_dst(int r0) {
    if (r0 < 6144) return r0;
    if (r0 < 8192) return r0 + 16;
    if (r0 < 12288) { const int p = (r0 - 8192) >> 8, w = (r0 - 8192) & 255; return (w < 128 ? 8208 : 12304) + 128 * p + (w & 127); }
    if (r0 < 16384) { const int p = (r0 - 12288) >> 8, w = (r0 - 12288) & 255; return (w < 128 ? 10256 : 14352) + 128 * p + (w & 127); }
    if (r0 < 20480) { const int p = (r0 - 16384) >> 8, w = (r0 - 16384) & 255; return (w < 128 ? 16400 : 18448) + 128 * p + (w & 127); }
    return 6144;
}
struct TrItem { const float* src; bf16_t* dst; int ldn, nvalid4; };
__device__ __forceinline__ void tr_load(f32x4 (&v)[16], const TrItem& t, int lane) {
    const int ks = lane >> 4, g = lane & 15;
#pragma unroll
    for (int i = 0; i < 16; ++i) v[i] = (g < t.nvalid4) ? __builtin_nontemporal_load((const f32x4*)(t.src + (size_t)(4 * i + ks) * t.ldn + 4 * g)) : (f32x4){0.f, 0.f, 0.f, 0.f};
}
__device__ __forceinline__ void tr_process(const f32x4 (&v)[16], const TrItem& t, LAS float* scr, int lane) {
    const int ks = lane >> 4, g = lane & 15;
#pragma unroll
    for (int i = 0; i < 16; ++i) { LAS float* w = scr + (4 * i + ks) * 65 + 4 * g; w[0] = v[i].x; w[1] = v[i].y; w[2] = v[i].z; w[3] = v[i].w; }
    asm volatile("s_waitcnt lgkmcnt(0)" ::: "memory");
    const int c = lane & 7;
#pragma unroll
    for (int j = 0; j < 8; ++j) { const int n = (lane >> 3) + 8 * j; const LAS float* s = scr + (8 * c) * 65 + n;
        u32x4 o; o.x = pk2(s[0 * 65], s[1 * 65]); o.y = pk2(s[2 * 65], s[3 * 65]); o.z = pk2(s[4 * 65], s[5 * 65]); o.w = pk2(s[6 * 65], s[7 * 65]);
        if (n < 4 * t.nvalid4 || t.nvalid4 == 16) *(u32x4*)(t.dst + (size_t)n * 2048 + 8 * c) = o; }
    asm volatile("s_waitcnt lgkmcnt(0)" ::: "memory");
}
__device__ __forceinline__ void rms_rows2_to_bf16(const float* xa, bf16_t* oa, const float* xb, bf16_t* ob, bool hasb, const float* gain, int lane) {
    const f32x4* ra = (const f32x4*)xa + lane; const f32x4* rb = (const f32x4*)(hasb ? xb : xa) + lane; const f32x4* gr = (const f32x4*)gain + lane;
    f32x4 v[8], w[8]; float s = 0.f, s2 = 0.f;
#pragma unroll
    for (int j = 0; j < 8; ++j) v[j] = __builtin_nontemporal_load(ra + 64 * j);
#pragma unroll
    for (int j = 0; j < 8; ++j) w[j] = __builtin_nontemporal_load(rb + 64 * j);
#pragma unroll
    for (int j = 0; j < 8; ++j) { s += (v[j].x * v[j].x + v[j].y * v[j].y) + (v[j].z * v[j].z + v[j].w * v[j].w); s2 += (w[j].x * w[j].x + w[j].y * w[j].y) + (w[j].z * w[j].z + w[j].w * w[j].w); }
    const float rstd = 1.0f / sqrtf(wave_sum(s) * (1.f / DM) + EPS), rstd2 = 1.0f / sqrtf(wave_sum(s2) * (1.f / DM) + EPS);
    unsigned long long* o8 = (unsigned long long*)oa + lane; unsigned long long* p8 = (unsigned long long*)ob + lane;
#pragma unroll
    for (int j = 0; j < 8; ++j) { const f32x4 g = gr[64 * j]; const f32x4 y = v[j] * rstd * g, z = w[j] * rstd2 * g;
        o8[64 * j] = (unsigned long long)pk2(y.x, y.y) | ((unsigned long long)pk2(y.z, y.w) << 32);
        if (hasb) p8[64 * j] = (unsigned long long)pk2(z.x, z.y) | ((unsigned long long)pk2(z.z, z.w) << 32); }
}
__device__ __forceinline__ void zero_bytes16(void* p, size_t nbytes, int gt, int ngt) {
    u32x4* q = (u32x4*)p; const size_t n = nbytes / 16;
    for (size_t i = gt; i < n; i += ngt) q[i] = (u32x4){0u, 0u, 0u, 0u};
}

__device__ __forceinline__ void p1_side_task(int c, LAS unsigned char* lds, const bf16_t* XN, const bf16_t* WIN, const float* b_f, float* LF, bf16_t* Kb, bf16_t* Vb, bf16_t* P1b) {
    const int tid = threadIdx.x, lane = tid & 63, w = __builtin_amdgcn_readfirstlane(tid >> 6), fr = lane & 15, fq = lane >> 4;
    const bf16_t* XM = XN + (size_t)MREAL * DM;
    const bf16_t* WF = WIN + (size_t)20480 * DM;
    int n0, n1;
    if (c < 64) { n0 = 2048 + 32 * c; n1 = n0 + 16; } else if (c < 128) { n0 = 4096 + 32 * (c - 64); n1 = n0 + 16; }
    else { const int ch0 = 16 * (c - 128); n0 = 8192 + 256 * (ch0 >> 7) + (ch0 & 127); n1 = n0 + 128; }
    const size_t lo_ = (size_t)fr * DM + 256 * w + 8 * fq;
    const bf16_t* P6[6] = {XN + (size_t)(32 * c) * DM + lo_, XN + (size_t)(32 * c + 16) * DM + lo_, XM + lo_, WF + lo_, WIN + (size_t)n0 * DM + lo_, WIN + (size_t)n1 * DM + lo_};
    bf16x8 fr6[6][8];
#pragma unroll
    for (int s = 0; s < 6; ++s)
#pragma unroll
        for (int i = 0; i < 8; ++i) fr6[s][i] = *(const bf16x8*)(P6[s] + 32 * i);
    f32x4 acc[5];
#pragma unroll
    for (int g = 0; g < 5; ++g) acc[g] = (f32x4){0.f, 0.f, 0.f, 0.f};
#pragma unroll
    for (int i = 0; i < 8; ++i) {
        acc[0] = __builtin_amdgcn_mfma_f32_16x16x32_bf16(fr6[0][i], fr6[3][i], acc[0], 0, 0, 0);
        acc[1] = __builtin_amdgcn_mfma_f32_16x16x32_bf16(fr6[1][i], fr6[3][i], acc[1], 0, 0, 0);
        acc[2] = __builtin_amdgcn_mfma_f32_16x16x32_bf16(fr6[2][i], fr6[3][i], acc[2], 0, 0, 0);
        acc[3] = __builtin_amdgcn_mfma_f32_16x16x32_bf16(fr6[4][i], fr6[2][i], acc[3], 0, 0, 0);
        acc[4] = __builtin_amdgcn_mfma_f32_16x16x32_bf16(fr6[5][i], fr6[2][i], acc[4], 0, 0, 0);
    }
    LAS f32x4* red = (LAS f32x4*)lds;
#pragma unroll
    for (int g = 0; g < 5; ++g) red[(w * 5 + g) * 64 + lane] = acc[g];
    __syncthreads();
    if (w == 0) {
#pragma unroll
        for (int g = 0; g < 5; ++g) { f32x4 s = red[g * 64 + lane];
#pragma unroll
            for (int ww = 1; ww < 8; ++ww) s += red[(ww * 5 + g) * 64 + lane];
            acc[g] = s; }
        const float bfh = b_f[fr];
#pragma unroll
        for (int g = 0; g < 3; ++g)
#pragma unroll
            for (int j = 0; j < 4; ++j) { const float xx = acc[g][j] + bfh; const float v = (fminf(xx, 0.f) - log1pf(__expf(-fabsf(xx)))) * LOG2E; const int m = 4 * fq + j;
                if (g < 2) { const int row = 32 * c + 16 * g + m; LF[(size_t)((row >> 12) * NH + fr) * KVROWS + 64 + (row & 4095)] = v; }
                else if (c == 0) { LF[(size_t)fr * KVROWS + 48 + m] = v; LF[(size_t)(NH + fr) * KVROWS + 48 + m] = v; } }
        if (c < 128) {
            bf16_t* T = (c < 64) ? Kb : Vb; const int col0 = (c < 64) ? 32 * c : 32 * (c - 64);
#pragma unroll
            for (int g = 0; g < 2; ++g)
#pragma unroll
                for (int j = 0; j < 4; ++j) { const bf16_t v = (bf16_t)(cvt_pk_bf16(acc[3 + g][j], 0.f) & 0xffffu); const int col = col0 + 16 * g + 4 * fq + j;
                    const size_t o_ = ((size_t)(col >> 7) * KVROWS + 48 + fr) * HD + (col & 127); T[o_] = v; T[o_ + (size_t)NH * KVROWS * HD] = v; }
        } else if (fr >= 14) {
            const int ch0 = 16 * (c - 128);
#pragma unroll
            for (int j = 0; j < 4; ++j) { const bf16_t v = (bf16_t)(cvt_pk_bf16(acc[3][j] * acc[4][j], 0.f) & 0xffffu); const int col = ch0 + 4 * fq + j;
                P1b[(size_t)(fr - 14) * DM + col] = v; P1b[(size_t)(P1ROWS + fr - 14) * DM + col] = v; }
        }
    }
    __syncthreads();
}

#define XB_TMO      128
#define XB_XCNT(j)  (256  + 64 * (j))
#define XB_XSUB(j)  (1280 + 64 * (j))
#define XB_XGEN(j)  (2304 + 64 * (j))
#define XB_TOP      3328
#define XB_TOPGEN   3392
#define XCD_BAR_WORDS 3456
#define XB_SPIN_CAP (1u << 22)
__device__ __forceinline__ unsigned xb_ld(unsigned* p)              { return __hip_atomic_load(p, __ATOMIC_RELAXED, __HIP_MEMORY_SCOPE_AGENT); }
__device__ __forceinline__ unsigned xb_add(unsigned* p, unsigned v) { return __hip_atomic_fetch_add(p, v, __ATOMIC_RELAXED, __HIP_MEMORY_SCOPE_AGENT); }
__device__ __forceinline__ unsigned xb_xcc_id() { return (unsigned)__builtin_amdgcn_s_getreg((3 << 11) | 20) & 0xFu; }
#define XB_SPIN(cond, bar) do { unsigned _sp = 0; while (cond) { __builtin_amdgcn_s_sleep(1); \
    if ((++_sp & 255u) == 0u) { if (xb_ld(&(bar)[XB_TMO])) break; if (_sp > XB_SPIN_CAP) { atomicAdd(&(bar)[XB_TMO], 1u); break; } } } } while (0)
struct XcdBarrier { unsigned* bar; unsigned x; volatile LAS unsigned* st; };
__device__ __forceinline__ XcdBarrier xcd_barrier_post(unsigned* bar, volatile LAS unsigned* st) {
    XcdBarrier b; b.bar = bar; b.x = xb_xcc_id(); b.st = st;
    if (threadIdx.x == 0) (void)xb_add(&bar[XB_XCNT(b.x)], 1u);
    return b;
}
__device__ __forceinline__ void xcd_barrier_complete(unsigned* bar, unsigned x, unsigned& nloc, unsigned& nx) {
    const unsigned G = gridDim.x * gridDim.y * gridDim.z;
    unsigned sum, cnt, mine, sp = 0u;
    for (;;) {
        sum = 0u; cnt = 0u; mine = 0u;
#pragma unroll
        for (unsigned j = 0; j < 16; ++j) { const unsigned c = xb_ld(&bar[XB_XCNT(j)]); sum += c; cnt += (c > 0u) ? 1u : 0u; mine = (j == x) ? c : mine; }
        if (sum == G) break;
        __builtin_amdgcn_s_sleep(1);
        if ((++sp & 255u) == 0u) { if (xb_ld(&bar[XB_TMO])) break; if (sp > XB_SPIN_CAP) { atomicAdd(&bar[XB_TMO], 1u); break; } }
    }
    nloc = mine > 0u ? mine : 1u; nx = cnt > 0u ? cnt : 1u;
}
__device__ __forceinline__ void xcd_barrier(const XcdBarrier& b) {
    asm volatile("s_waitcnt vmcnt(0)" ::: "memory");
    __syncthreads();
    if (threadIdx.x == 0) {
        unsigned* bar = b.bar;
        __builtin_amdgcn_s_waitcnt(0);
        unsigned nloc = b.st[0], nx = b.st[1];
        if (nloc == 0u) { xcd_barrier_complete(bar, b.x, nloc, nx); b.st[0] = nloc; b.st[1] = nx; }
        const unsigned old = xb_add(&bar[XB_XSUB(b.x)], 1u);
        const unsigned gen = old / nloc;
        if (old + 1u == (gen + 1u) * nloc) {
            __builtin_amdgcn_fence(__ATOMIC_RELEASE, "agent");
            asm volatile("s_waitcnt vmcnt(0)" ::: "memory");
            const unsigned og = xb_add(&bar[XB_TOP], 1u);
            const unsigned tg = og / nx;
            if (og + 1u == (tg + 1u) * nx) xb_add(&bar[XB_TOPGEN], 1u);
            else XB_SPIN(xb_ld(&bar[XB_TOPGEN]) == tg, bar);
            __builtin_amdgcn_fence(__ATOMIC_ACQUIRE, "agent");
            xb_add(&bar[XB_XGEN(b.x)], 1u);
            asm volatile("s_waitcnt vmcnt(0)" ::: "memory");
        } else {
            XB_SPIN(xb_ld(&bar[XB_XGEN(b.x)]) == gen, bar);
            __builtin_amdgcn_fence(__ATOMIC_ACQUIRE, "agent");
            asm volatile("s_waitcnt vmcnt(0)" ::: "memory");
        }
    }
    __syncthreads();
}

__device__ __forceinline__ void grid_barrier(unsigned* ctr, unsigned target) {
    asm volatile("s_waitcnt vmcnt(0)" ::: "memory");
    __syncthreads();
    if (threadIdx.x == 0) {
        __builtin_amdgcn_fence(__ATOMIC_RELEASE, "agent");
        asm volatile("s_waitcnt vmcnt(0)" ::: "memory");
        __hip_atomic_fetch_add(ctr, 1u, __ATOMIC_RELAXED, __HIP_MEMORY_SCOPE_AGENT);
        while (__hip_atomic_load(ctr, __ATOMIC_RELAXED, __HIP_MEMORY_SCOPE_AGENT) < target) __builtin_amdgcn_s_sleep(2);
        __builtin_amdgcn_fence(__ATOMIC_ACQUIRE, "agent");
        asm volatile("s_waitcnt vmcnt(0)" ::: "memory");
    }
    __syncthreads();
}

__global__ void __launch_bounds__(NTHREADS, 2) fox_fwd(Args args) {
    extern __shared__ __attribute__((aligned(16))) unsigned char lds[];
    if (args.ph_lo < 0) cg::this_grid().sync();
#define tid ((int)threadIdx.x)
#define lane (tid & 63)
    const int wave = __builtin_amdgcn_readfirstlane(tid >> 6);
    const int G = gridDim.x, bx = blockIdx.x, vcu = (G % 8 == 0) ? (bx % 8) * (G / 8) + bx / 8 : bx;
    unsigned char* ws = args.ws;
    const float* x = args.in[0]; const float* meta = args.in[1]; const float* norm_gain = args.in[2]; const float* w_in = args.in[3];
    const float* b_f = args.in[4]; const float* conv_w = args.in[5]; const float* w_att_o = args.in[6]; const float* w_conv_o = args.in[7];
    const float* w_out = args.in[8]; const float* final_gain = args.in[9];
    bf16_t* WIN = (bf16_t*)(ws + WS_WIN); bf16_t* WATT = (bf16_t*)(ws + WS_WATT); bf16_t* WCONV = (bf16_t*)(ws + WS_WCONV); bf16_t* WOUT = (bf16_t*)(ws + WS_WOUT);
    bf16_t* XN = (bf16_t*)(ws + WS_XN); bf16_t* Qb = (bf16_t*)(ws + WS_Q); bf16_t* Kb = (bf16_t*)(ws + WS_K); bf16_t* Vb = (bf16_t*)(ws + WS_V);
    bf16_t* Zb = (bf16_t*)(ws + WS_Z); bf16_t* P1b = (bf16_t*)(ws + WS_P1); bf16_t* P2b = (bf16_t*)(ws + WS_P2); bf16_t* Rb = (bf16_t*)(ws + WS_R);
    bf16_t* S2b = (bf16_t*)(ws + WS_S2); bf16_t* AATT = (bf16_t*)(ws + WS_AATT); bf16_t* ACONV = (bf16_t*)(ws + WS_ACONV); bf16_t* MG = (bf16_t*)(ws + WS_MG);
    float* LF = (float*)(ws + WS_LF); float* SS = (float*)(ws + WS_SS);
    const int lo = args.ph_lo, hi = args.ph_hi;
    volatile LAS unsigned* xst = (volatile LAS unsigned*)((LAS unsigned char*)lds + LDS_BYTES - 64);
    if (tid < 16) xst[tid] = 0u;
    __syncthreads();
    XcdBarrier xbar; xbar.bar = (unsigned*)(ws + WS_CTL) + 8192; xbar.x = 0; xbar.st = xst;
    if (hi - lo > 1) xbar = xcd_barrier_post((unsigned*)(ws + WS_CTL) + 8192, xst);
#define IN(k) (lo <= (k) && (k) < hi)
#define SEAM(k) do { if (IN(k) && IN((k) + 1)) { xcd_barrier(xbar); } } while (0)
#define REP(k) for (int rep_ = 0; rep_ < ((PROBE_REPEAT == (k)) ? 2 : 1); ++rep_)
#define REPBAR(k) do { if (PROBE_REPEAT == (k) && rep_ == 0) grid_barrier((unsigned*)(ws + WS_CTL) + 64 * (8 + (k)), (unsigned)G); } while (0)
    const int gw = vcu * NWAVES + wave, NGW = G * NWAVES, ngt = G * NTHREADS;
#define gt (bx * NTHREADS + tid)

    if (IN(0)) REP(0) {
        LAS float* scr = (LAS float*)((LAS unsigned char*)lds + wave * 16640);
        constexpr int NG_IN = 321, I_IN = NG_IN * 32, I_SQ = 32 * 32, NITEMS = I_IN + 3 * I_SQ;
#define TR_DECODE(T_, it_) do { int r_ = (it_); if (r_ < I_IN) { const bool tail_ = r_ >= 320 * 32; const int kb = tail_ ? (r_ - 320 * 32) : (((r_ >> 2) & 1) | (((r_ >> 3) & 15) << 1)), grp = tail_ ? 320 : ((r_ & 3) | ((r_ >> 7) << 2)); T_.src = w_in + (size_t)(kb * 64) * N_IN + src_col_of_dst(grp * 64); T_.dst = WIN + (size_t)(grp * 64) * 2048 + kb * 64; T_.ldn = N_IN; T_.nvalid4 = (grp == 320) ? 4 : 16; } \
            else { r_ -= I_IN; const int which = r_ / I_SQ; r_ -= which * I_SQ; const int kb = ((r_ >> 2) & 1) | (((r_ >> 3) & 15) << 1), grp = (r_ & 3) | ((r_ >> 7) << 2); T_.src = (which == 0 ? w_att_o : which == 1 ? w_conv_o : w_out) + (size_t)(kb * 64) * DM + grp * 64; \
                   T_.dst = (which == 0 ? WATT : which == 1 ? WCONV : WOUT) + (size_t)(grp * 64) * 2048 + kb * 64; T_.ldn = DM; T_.nvalid4 = 16; } } while (0)
        {
            f32x4 va[16], vb[16]; TrItem ta, tb; int it = gw;
            if (it < NITEMS) { TR_DECODE(ta, it); tr_load(va, ta, lane); }
            while (it < NITEMS) {
                int it2 = it + NGW; if (it2 < NITEMS) { TR_DECODE(tb, it2); tr_load(vb, tb, lane); }
                tr_process(va, ta, scr, lane);
                it = it2; if (it >= NITEMS) break;
                it2 = it + NGW; if (it2 < NITEMS) { TR_DECODE(ta, it2); tr_load(va, ta, lane); }
                tr_process(vb, tb, scr, lane);
                it = it2;
            }
        }
#undef TR_DECODE
        for (int m = gw; m < MREAL + NMETA; m += 2 * NGW) { const int m2 = m + NGW;
            rms_rows2_to_bf16(m < MREAL ? x + (size_t)m * DM : meta + (size_t)(m - MREAL) * DM, XN + (size_t)m * DM,
                              m2 < MREAL ? x + (size_t)m2 * DM : meta + (size_t)(m2 - MREAL) * DM, XN + (size_t)m2 * DM, m2 < MREAL + NMETA, norm_gain, lane); }
        for (int bh = 0; bh < NB * NH; ++bh) { zero_bytes16(Kb + (size_t)bh * KVROWS * HD, (size_t)48 * HD * 2, gt, ngt); zero_bytes16(Vb + (size_t)bh * KVROWS * HD, (size_t)48 * HD * 2, gt, ngt); }
        REPBAR(0);
    }
    SEAM(0);
    if (IN(1)) REP(1) {
        pg8::Gemm g{XN, WIN, nullptr, nullptr, MREAL, 20480, DM}; pg8::StaticOrder<1> S; S.init(MREAL, 20480, G, bx);
        pg8::EpiProj E{Qb, Kb, Vb, Zb, P1b, P2b, Rb, S2b};
        pg8::gemm_phase<pg8::EpiProj, pg8::StaticOrder<1>, 1>((LAS unsigned char*)lds, g, S, E);
        for (int srep = 0; srep < SIDE_REPS; ++srep) for (int c = bx; c < 256; c += G) p1_side_task(c, (LAS unsigned char*)lds, XN, WIN, b_f, LF, Kb, Vb, P1b);
        REPBAR(1);
    }
    SEAM(1);
    if (IN(2)) REP(2) {
        const att::Tensors T{Qb, Kb, Vb, Zb, AATT, LF};
        att::attn_phase((char*)lds, T, vcu, G);
        {
            const int ch = (tid & 255) * 8, rsub = tid >> 8, rows_per = MREAL / G;
            const f32x4 w0a = *(const f32x4*)(conv_w + ch), w0b = *(const f32x4*)(conv_w + ch + 4), w1a = *(const f32x4*)(conv_w + DM + ch), w1b = *(const f32x4*)(conv_w + DM + ch + 4),
                        w2a = *(const f32x4*)(conv_w + 2 * DM + ch), w2b = *(const f32x4*)(conv_w + 2 * DM + ch + 4);
#define CONV2(W, A0, A1, A2, GW, wa, wb, wc_, j0) W = cvt_pk_bf16(bf_lo(GW) * (wa[j0] * bf_lo(A0) + wb[j0] * bf_lo(A1) + wc_[j0] * bf_lo(A2)), bf_hi(GW) * (wa[j0 + 1] * bf_hi(A0) + wb[j0 + 1] * bf_hi(A1) + wc_[j0 + 1] * bf_hi(A2)))
            const bool band = (MREAL % G == 0) && ((MREAL / G) % 2 == 0);
            const int r_begin = band ? vcu * rows_per + rsub : (gt >> 8), r_end = band ? (vcu + 1) * rows_per : MREAL, r_step = band ? 2 : (ngt >> 8);
            for (int row = r_begin; row < r_end; row += r_step) {
                const int b = row >> 12; const size_t pr = (size_t)(row + 2 * b) * DM + ch;
                const u32x4 a0 = *(const u32x4*)(P1b + pr), a1 = *(const u32x4*)(P1b + pr + DM), a2 = *(const u32x4*)(P1b + pr + 2 * DM), gg = *(const u32x4*)(P2b + (size_t)row * DM + ch);
                u32x4 o;
                CONV2(o.x, a0.x, a1.x, a2.x, gg.x, w0a, w1a, w2a, 0); CONV2(o.y, a0.y, a1.y, a2.y, gg.y, w0a, w1a, w2a, 2);
                CONV2(o.z, a0.z, a1.z, a2.z, gg.z, w0b, w1b, w2b, 0); CONV2(o.w, a0.w, a1.w, a2.w, gg.w, w0b, w1b, w2b, 2);
                *(u32x4*)(ACONV + (size_t)row * DM + ch) = o;
            }
#undef CONV2
        }
        REPBAR(2);
    }
    SEAM(2);
    if (IN(3)) REP(3) {
        pg8::Gemm g{AATT, WATT, ACONV, WCONV, MREAL, DM, DM}; pg8::StaticOrder<2> S; S.init(MREAL, DM, G, bx);
        pg8::EpiMerge E{Rb, S2b, MG};
        pg8::gemm_phase<pg8::EpiMerge, pg8::StaticOrder<2>, 2>((LAS unsigned char*)lds, g, S, E);
        REPBAR(3);
    }
    SEAM(3);
    const bool fused_norm = (G == 256) && IN(4) && IN(5);
    if (IN(4)) {
        pg8::Gemm g{MG, WOUT, nullptr, nullptr, MREAL, DM, DM}; pg8::StaticOrder<1> S; S.init(MREAL, DM, G, bx);
        if (fused_norm) { pg8::EpiOutNorm E{x, args.out, final_gain, SS, (unsigned*)(ws + WS_CTL) + 2048};
            pg8::gemm_phase<pg8::EpiOutNorm, pg8::StaticOrder<1>, 1, false, true>((LAS unsigned char*)lds, g, S, E); }
        else { pg8::EpiOut E{x, args.out, SS};
            pg8::gemm_phase<pg8::EpiOut, pg8::StaticOrder<1>, 1>((LAS unsigned char*)lds, g, S, E); }
    }
    if (!fused_norm) {
    SEAM(4);
    if (IN(5)) {
        for (int m = gw; m < MREAL; m += NGW) {
            float s = (lane < 32) ? SS[(size_t)m * 32 + lane] : 0.f; s = wave_sum(s);
            const float rstd = 1.0f / sqrtf(s * (1.f / DM) + EPS);
            f32x4* o = (f32x4*)(args.out + (size_t)m * DM) + lane; const f32x4* gr = (const f32x4*)final_gain + lane;
#pragma unroll
            for (int j = 0; j < 8; ++j) { const f32x4 y = o[64 * j]; o[64 * j] = y * rstd * gr[64 * j]; }
        }
    }
    }
#undef IN
#undef SEAM
#undef REP
#undef REPBAR
#undef tid
#undef lane
#undef gt
}

extern "C" void kernel_launch(void* const* d_in, const int* in_sizes, int n_in, void* d_out, int out_size, void* d_ws, size_t ws_size, hipStream_t stream) {
    static int grid = 0;
    if (grid == 0) {
        if (n_in != 10 || in_sizes[0] != MREAL * DM || out_size != MREAL * DM || ws_size < WS_END) {
            fprintf(stderr, "kernel_launch: unexpected shapes (n_in %d, in0 %d, out %d, ws %zu < %zu?)\n", n_in, n_in > 0 ? in_sizes[0] : -1, out_size, ws_size, (size_t)WS_END); grid = -1; return; }
        int dev = 0, cus = 0, per_cu = 0;
        (void)hipGetDevice(&dev); (void)hipDeviceGetAttribute(&cus, hipDeviceAttributeMultiprocessorCount, dev);
        if (hipFuncSetAttribute((const void*)fox_fwd, hipFuncAttributeMaxDynamicSharedMemorySize, LDS_BYTES) != hipSuccess) { fprintf(stderr, "kernel_launch: hipFuncSetAttribute failed\n"); grid = -1; return; }
        if (hipOccupancyMaxActiveBlocksPerMultiprocessor(&per_cu, (const void*)fox_fwd, NTHREADS, LDS_BYTES) != hipSuccess || per_cu < 1) { fprintf(stderr, "kernel_launch: occupancy query says %d\n", per_cu); per_cu = 1; }
        (void)hipGetLastError();
        if (cus <= 0) cus = 256;
        grid = cus;
    }
    if (grid < 0) return;
    Args a{};
    for (int i = 0; i < 10; ++i) a.in[i] = (const float*)d_in[i];
    a.out = (float*)d_out; a.ws = (unsigned char*)d_ws;
#if MK_COOP
    a.ph_lo = 0; a.ph_hi = 6;
    (void)hipMemsetAsync((unsigned char*)d_ws + WS_CTL, 0, 65536, stream);
    void* kargs[] = {&a};
    hipError_t e = hipLaunchCooperativeKernel((const void*)fox_fwd, dim3(grid), dim3(NTHREADS), kargs, LDS_BYTES, stream);
    if (e != hipSuccess) fprintf(stderr, "kernel_launch: cooperative launch failed: %s (grid %d)\n", hipGetErrorString(e), grid);
#else
    for (int p = 0; p < 6; ++p) { a.ph_lo = p; a.ph_hi = p + 1; hipLaunchKernelGGL(fox_fwd, dim3(grid), dim3(NTHREADS), LDS_BYTES, stream, a); }
#endif
}
```

```cpp
#include <hip/hip_runtime.h>
#include <hip/hip_cooperative_groups.h>
#include <cstdio>
#include <cstdint>
namespace cg = cooperative_groups;

#ifndef PROBE_REPEAT
#define PROBE_REPEAT -1
#endif
#ifndef SIDE_REPS
#define SIDE_REPS 1
#endif
#ifndef MK_COOP
#define MK_COOP 1
#endif

#define LAS __attribute__((address_space(3)))
typedef unsigned short bf16_t;
typedef short bf16x8 __attribute__((ext_vector_type(8)));
typedef short s16x4 __attribute__((ext_vector_type(4)));
typedef float f32x4 __attribute__((ext_vector_type(4)));
typedef float f32x2 __attribute__((ext_vector_type(2)));
typedef float f32x16 __attribute__((ext_vector_type(16)));
typedef unsigned u32x4 __attribute__((ext_vector_type(4)));
typedef unsigned u32x2 __attribute__((ext_vector_type(2)));

constexpr int DM = 2048, NB = 2, SEQ = 4096, NMETA = 16, NH = 16, HD = 128;
constexpr int MREAL = NB * SEQ;
constexpr int MALL = MREAL + 256;
constexpr int N_IN = 20496;
constexpr int NPROJ = 81 * 256;
constexpr int KVROWS = 64 + SEQ;
constexpr int P1ROWS = 2 + SEQ;
constexpr float EPS = 1e-6f;
constexpr float LOG2E = 1.4426950408889634f;
constexpr float QSCALE = 0.08838834764831845f * 1.4426950408889634f;

constexpr size_t MiB = 1u << 20;
constexpr size_t WS_WIN = 0, WS_WATT = 81 * MiB, WS_WCONV = 89 * MiB, WS_WOUT = 97 * MiB, WS_XN = 105 * MiB, WS_Q = 138 * MiB,
                 WS_K = 170 * MiB, WS_V = 203 * MiB, WS_Z = 236 * MiB, WS_P1 = 268 * MiB, WS_P2 = 301 * MiB, WS_R = 333 * MiB,
                 WS_S2 = 365 * MiB, WS_AATT = 397 * MiB, WS_ACONV = 429 * MiB, WS_MG = 461 * MiB, WS_LF = 493 * MiB, WS_SS = 494 * MiB,
                 WS_CTL = 495 * MiB, WS_END = 496 * MiB;

__device__ __forceinline__ unsigned cvt_pk_bf16(float lo, float hi) { unsigned r; asm volatile("v_cvt_pk_bf16_f32 %0, %1, %2" : "=v"(r) : "v"(lo), "v"(hi)); return r; }
__device__ __forceinline__ float bf_lo(unsigned w) { return __uint_as_float(w << 16); }
__device__ __forceinline__ float bf_hi(unsigned w) { return __uint_as_float(w & 0xffff0000u); }
__device__ __forceinline__ float sigmoidf_(float x) { return __builtin_amdgcn_rcpf(1.0f + __expf(-x)); }
__device__ __forceinline__ float siluf_(float x) { return x * sigmoidf_(x); }

namespace pg8 {
constexpr int BM = 256, BK = 64, HALF = 128, HTB = HALF * BK * 2, STAGE_BYTES = 8 * HTB, NXCD = 8, WGM = 8;
__host__ __device__ __forceinline__ int lds_byte(int r, int c) { const int st = (r >> 4) * 2 + (c >> 5), rr = r & 15, cc = c & 31, ob = rr * 64 + cc * 2; return st * 1024 + (ob ^ (((ob >> 9) & 1) << 5)); }
__host__ __device__ __forceinline__ void stage_rc(int b, int& R, int& C) { const int st = b / 1024, sb = b % 1024, swz = sb ^ (((sb >> 9) & 1) << 5); R = (st >> 1) * 16 + swz / 64; C = (st & 1) * 32 + (swz % 64) / 2; }
__host__ __device__ __forceinline__ int perm32(int rho) { const int n = rho >> 4, i = rho & 15; return 8 * (i >> 2) + 4 * n + (i & 3); }

struct Unit { int pm, pn, seg; };
struct Gemm { const bf16_t* A; const bf16_t* Bt; const bf16_t* A2; const bf16_t* Bt2; int M, N, K; };

template <int NSEG> struct StaticOrder {
    int nM, nN, nwg, G, c;
    __device__ void init(int M, int N, int G_, int c_) { nM = M / BM; nN = N / BM; nwg = nM * nN; G = G_; c = c_; }
    __device__ bool next(int i, Unit& u) const {
        const int ti = (NSEG == 2) ? (i >> 1) : i; u.seg = (NSEG == 2) ? (i & 1) : 0;
        const long L = (long)ti * G + c; if (L >= nwg) return false;
        int wgid = (int)L; { const int q = nwg / NXCD, r = nwg % NXCD, xcd = wgid % NXCD, off = wgid / NXCD; wgid = (xcd < r ? xcd * (q + 1) : r * (q + 1) + (xcd - r) * q) + off; }
        const int nig = WGM * nN, gid = wgid / nig, fm = gid * WGM, gsz = (nM - fm) < WGM ? (nM - fm) : WGM;
        u.pm = fm + ((wgid % nig) % gsz); u.pn = (wgid % nig) / gsz; return true;
    }
};

typedef f32x4 Acc[2][2][4][2];

template <class Epi, class Sched, int NSEG, bool ALIGN_EPI = true, bool AFTER_DRAIN = false>
__device__ __forceinline__ void gemm_phase(LAS unsigned char* lds, const Gemm g, const Sched& S, const Epi& E) {
    const int tid = threadIdx.x, wid = __builtin_amdgcn_readfirstlane(tid >> 6), lane = tid & 63, wr = wid >> 2, wc = wid & 3, fr = lane & 15, fq = lane >> 4;
    const int K = g.K, nt = K / BK;
    unsigned voffA[2], voffB[2];
#pragma unroll
    for (int i = 0; i < 2; ++i) { int R, C; stage_rc(tid * 16 + i * 8192, R, C); const int Rb = Epi::PERM ? ((R & ~31) + perm32(R & 31)) : R;
        voffA[i] = (unsigned)(R * K + C) * 2u; voffB[i] = (unsigned)(Rb * K + C) * 2u; }
    const size_t kstep = (size_t)(BK * 2);
    const size_t hstep = (size_t)HALF * K * 2;
    const size_t tstep = 2 * hstep;
    const unsigned ldsw = (unsigned)wid * 1024u;
    const int aoff = lds_byte(wr * 64 + fr, fq * 8), boff = lds_byte(wc * 32 + fr, fq * 8);
#define PG8_SA(b, h) (((b) * 2 + (h)) * HTB)
#define PG8_SB(b, h) ((4 + (b) * 2 + (h)) * HTB)
#define PG8_STAGE(bufoff, gbase, voff) do { _Pragma("unroll") for (int _i = 0; _i < 2; ++_i) \
        __builtin_amdgcn_global_load_lds((const unsigned*)((const char*)(gbase) + (voff)[_i]), (LAS unsigned*)(lds + (bufoff) + ldsw + _i * 8192), 16, 0, 0); } while (0)
#define PG8_LDA(dst, b, h) do { _Pragma("unroll") for (int m = 0; m < 4; ++m) _Pragma("unroll") for (int k = 0; k < 2; ++k) dst[m][k] = *(const LAS bf16x8*)(lds + PG8_SA(b, h) + aoff + m * 2048 + k * 1024); } while (0)
#define PG8_LDB(dst, b, h) do { _Pragma("unroll") for (int n = 0; n < 2; ++n) _Pragma("unroll") for (int k = 0; k < 2; ++k) dst[n][k] = *(const LAS bf16x8*)(lds + PG8_SB(b, h) + boff + n * 2048 + k * 1024); } while (0)
#define PG8_MMA(ai, bj, At, Bt) do { __builtin_amdgcn_s_setprio(1); _Pragma("unroll") for (int m = 0; m < 4; ++m) _Pragma("unroll") for (int n = 0; n < 2; ++n) _Pragma("unroll") for (int k = 0; k < 2; ++k) \
        acc[ai][bj][m][n] = __builtin_amdgcn_mfma_f32_16x16x32_bf16(Bt[n][k], At[m][k], acc[ai][bj][m][n], 0, 0, 0); __builtin_amdgcn_s_setprio(0); } while (0)
#define PG8_WAIT_V(n) asm volatile("s_waitcnt vmcnt(" #n ")" ::: "memory")
#define PG8_WAIT_L(n) asm volatile("s_waitcnt lgkmcnt(" #n ")" ::: "memory")
#define PG8_BAR __builtin_amdgcn_s_barrier()
#define PG8_SCHED __builtin_amdgcn_sched_barrier(0)
#define PG8_ABASE(u) ((const char*)(((NSEG == 2) && (u).seg) ? g.A2 : g.A) + (size_t)(u).pm * tstep)
#define PG8_BBASE(u) ((const char*)(((NSEG == 2) && (u).seg) ? g.Bt2 : g.Bt) + (size_t)(u).pn * tstep)
    Unit cur, nxt; int ui = 0;
    if (!S.next(0, cur)) return;
    f32x4 acc[2][2][4][2];
#pragma unroll
    for (int a = 0; a < 2; ++a)
#pragma unroll
        for (int b = 0; b < 2; ++b)
#pragma unroll
            for (int m = 0; m < 4; ++m)
#pragma unroll
                for (int n = 0; n < 2; ++n) acc[a][b][m][n] = (f32x4){0.f, 0.f, 0.f, 0.f};
    bf16x8 At[4][2], B0[2][2], B1[2][2];
    const char* cA = PG8_ABASE(cur); const char* cB = PG8_BBASE(cur);
    PG8_STAGE(PG8_SB(0, 0), cB, voffB); PG8_STAGE(PG8_SB(0, 1), cB + hstep, voffB); PG8_STAGE(PG8_SA(0, 0), cA, voffA); PG8_STAGE(PG8_SA(0, 1), cA + hstep, voffA);
    if (wr == 1) PG8_BAR;
    PG8_WAIT_V(2); PG8_BAR;
    PG8_STAGE(PG8_SB(1, 0), cB + kstep, voffB); PG8_STAGE(PG8_SA(1, 0), cA + kstep, voffA); PG8_STAGE(PG8_SB(1, 1), cB + hstep + kstep, voffB);
    PG8_WAIT_V(6); PG8_BAR;
    for (;;) {
        const bool has_next = S.next(ui + 1, nxt);
        const char* nA = has_next ? PG8_ABASE(nxt) : cA; const char* nB = has_next ? PG8_BBASE(nxt) : cB;
        for (int t = 0; t < nt; t += 2) {
            const bool last = (t == nt - 2);
            const char* a1 = cA + (size_t)(t + 1) * kstep;
            const char* a2 = last ? nA : cA + (size_t)(t + 2) * kstep; const char* b2 = last ? nB : cB + (size_t)(t + 2) * kstep;
            const char* a3 = a2 + kstep; const char* b3 = b2 + kstep;
            PG8_LDB(B0, 0, 0); PG8_LDB(B1, 0, 1); PG8_SCHED; PG8_LDA(At, 0, 0); PG8_STAGE(PG8_SA(1, 1), a1 + hstep, voffA);
            PG8_WAIT_V(8); PG8_WAIT_L(0); PG8_BAR; PG8_MMA(0, 0, At, B0); PG8_MMA(0, 1, At, B1); PG8_BAR; PG8_SCHED;
            PG8_LDA(At, 0, 1); PG8_STAGE(PG8_SB(0, 0), b2, voffB); PG8_STAGE(PG8_SB(0, 1), b2 + hstep, voffB); PG8_STAGE(PG8_SA(0, 0), a2, voffA);
            PG8_WAIT_V(8); PG8_WAIT_L(0); PG8_BAR; PG8_MMA(1, 0, At, B0); PG8_MMA(1, 1, At, B1); PG8_BAR; PG8_SCHED;
            PG8_LDB(B0, 1, 0); PG8_LDB(B1, 1, 1); PG8_SCHED; PG8_LDA(At, 1, 0); PG8_STAGE(PG8_SA(0, 1), a2 + hstep, voffA);
            PG8_WAIT_V(8); PG8_WAIT_L(0); PG8_BAR; PG8_MMA(0, 0, At, B0); PG8_MMA(0, 1, At, B1); PG8_BAR; PG8_SCHED;
            PG8_LDA(At, 1, 1); PG8_STAGE(PG8_SB(1, 0), b3, voffB); PG8_STAGE(PG8_SB(1, 1), b3 + hstep, voffB); PG8_STAGE(PG8_SA(1, 0), a3, voffA);
            PG8_WAIT_V(8); PG8_WAIT_L(0); PG8_BAR; PG8_MMA(1, 0, At, B0); PG8_MMA(1, 1, At, B1); PG8_BAR; PG8_SCHED;
        }
        if constexpr (ALIGN_EPI) { if (wr == 0) PG8_BAR; }
        const bool midseg = (NSEG == 2) && (cur.seg == 0);
        if (midseg) E.mid(acc, cur, wr, wc, fr, fq); else if constexpr (!AFTER_DRAIN) E(acc, cur, wr, wc, fr, fq);
        if (!has_next) break;
        if (!midseg) {
#pragma unroll
            for (int a = 0; a < 2; ++a)
#pragma unroll
                for (int b = 0; b < 2; ++b)
#pragma unroll
                    for (int m = 0; m < 4; ++m)
#pragma unroll
                        for (int n = 0; n < 2; ++n) acc[a][b][m][n] = (f32x4){0.f, 0.f, 0.f, 0.f};
        }
        cur = nxt; cA = nA; cB = nB; ++ui;
        if constexpr (ALIGN_EPI) { if (wr == 1) PG8_BAR; }
    }
    PG8_WAIT_V(0);
    if constexpr (!ALIGN_EPI) { if (wr == 0) PG8_BAR; }
    PG8_BAR;
    if constexpr (AFTER_DRAIN) E.fused(acc, cur, wr, wc, fr, fq, lds, wid, lane);
#undef PG8_SA
#undef PG8_SB
#undef PG8_STAGE
#undef PG8_LDA
#undef PG8_LDB
#undef PG8_MMA
#undef PG8_WAIT_V
#undef PG8_WAIT_L
#undef PG8_BAR
#undef PG8_SCHED
#undef PG8_ABASE
#undef PG8_BBASE
}

__device__ __forceinline__ u32x4 pack8(f32x4 v0, f32x4 v1) { u32x4 w; w.x = cvt_pk_bf16(v0[0], v0[1]); w.y = cvt_pk_bf16(v0[2], v0[3]); w.z = cvt_pk_bf16(v1[0], v1[1]); w.w = cvt_pk_bf16(v1[2], v1[3]); return w; }

struct EpiProj {
    static constexpr bool PERM = true;
    bf16_t *Q, *K, *V, *Z, *P1, *P2, *R, *S2;
    __device__ __forceinline__ void mid(Acc&, const Unit&, int, int, int, int) const {}
    __device__ __forceinline__ void operator()(const Acc& acc, const Unit& u, int wr, int wc, int fr, int fq) const {
        const int pm = u.pm, pn = u.pn; const int b = pm >> 4;
        const int rloc = wr * 64 + fr, cl = wc * 32 + 8 * fq;
        if (pn < 32) {
            const int kind = pn >> 3, colt = (pn & 7) * 256 + cl;
            if (kind == 0 || kind == 3) {
                bf16_t* base = (kind == 0 ? Q : Z) + (size_t)(pm * 256 + rloc) * DM + colt;
#pragma unroll
                for (int ai = 0; ai < 2; ++ai)
#pragma unroll
                    for (int m = 0; m < 4; ++m)
#pragma unroll
                        for (int bj = 0; bj < 2; ++bj) { f32x4 v0 = acc[ai][bj][m][0], v1 = acc[ai][bj][m][1];
                            if (kind == 0) { v0 = v0 * QSCALE; v1 = v1 * QSCALE; }
                            else {
#pragma unroll
                                for (int j = 0; j < 4; ++j) { v0[j] = siluf_(v0[j]); v1[j] = siluf_(v1[j]); } }
                            *(u32x4*)(base + (size_t)(ai * 128 + m * 16) * DM + bj * 128) = pack8(v0, v1); }
            } else {
                bf16_t* base = (kind == 1 ? K : V) + ((size_t)(b * NH + 2 * (pn & 7)) * KVROWS + 64 + (pm & 15) * 256 + rloc) * HD + cl;
#pragma unroll
                for (int ai = 0; ai < 2; ++ai)
#pragma unroll
                    for (int m = 0; m < 4; ++m)
#pragma unroll
                        for (int bj = 0; bj < 2; ++bj) *(u32x4*)(base + (size_t)bj * KVROWS * HD + (size_t)(ai * 128 + m * 16) * HD) = pack8(acc[ai][bj][m][0], acc[ai][bj][m][1]);
            }
        } else {
            const int kind = (pn - 32) >> 4, p = (pn - 32) & 15, col = p * 128 + cl;
            if (kind == 0) {
                bf16_t* base = P1 + (size_t)(pm * 256 + 2 + 2 * b + rloc) * DM + col;
#pragma unroll
                for (int ai = 0; ai < 2; ++ai)
#pragma unroll
                    for (int m = 0; m < 4; ++m) __builtin_nontemporal_store(pack8(acc[ai][0][m][0] * acc[ai][1][m][0], acc[ai][0][m][1] * acc[ai][1][m][1]), (u32x4*)(base + (size_t)(ai * 128 + m * 16) * DM));
            } else if (kind == 1) {
                bf16_t* base = P2 + (size_t)(pm * 256 + rloc) * DM + col;
#pragma unroll
                for (int ai = 0; ai < 2; ++ai)
#pragma unroll
                    for (int m = 0; m < 4; ++m) { f32x4 v0, v1;
#pragma unroll
                        for (int j = 0; j < 4; ++j) { v0[j] = acc[ai][0][m][0][j] * siluf_(acc[ai][1][m][0][j]); v1[j] = acc[ai][0][m][1][j] * siluf_(acc[ai][1][m][1][j]); }
                        __builtin_nontemporal_store(pack8(v0, v1), (u32x4*)(base + (size_t)(ai * 128 + m * 16) * DM)); }
            } else {
                const size_t o0 = (size_t)(pm * 256 + rloc) * DM + col;
#pragma unroll
                for (int ai = 0; ai < 2; ++ai)
#pragma unroll
                    for (int m = 0; m < 4; ++m) { f32x4 r0, r1, s0, s1;
#pragma unroll
                        for (int j = 0; j < 4; ++j) { const float e1a = 1.0f + __expf(-acc[ai][0][m][0][j]), e2a = 1.0f + __expf(-acc[ai][1][m][0][j]);
                            const float e1b = 1.0f + __expf(-acc[ai][0][m][1][j]), e2b = 1.0f + __expf(-acc[ai][1][m][1][j]);
                            s0[j] = __builtin_amdgcn_rcpf(e2a); s1[j] = __builtin_amdgcn_rcpf(e2b); r0[j] = e2a * __builtin_amdgcn_rcpf(e1a); r1[j] = e2b * __builtin_amdgcn_rcpf(e1b); }
                        const size_t o = o0 + (size_t)(ai * 128 + m * 16) * DM;
                        __builtin_nontemporal_store(pack8(r0, r1), (u32x4*)(R + o)); __builtin_nontemporal_store(pack8(s0, s1), (u32x4*)(S2 + o)); }
            }
        }
    }
};

struct EpiMerge {
    static constexpr bool PERM = true;
    const bf16_t *R, *S2; bf16_t* MG;
    __device__ __forceinline__ void mid(Acc& acc, const Unit& u, int wr, int wc, int fr, int fq) const {
        const bf16_t* base = R + (size_t)(u.pm * 256 + wr * 64 + fr) * DM + u.pn * 256 + wc * 32 + 8 * fq;
#pragma unroll
        for (int ai = 0; ai < 2; ++ai)
#pragma unroll
            for (int m = 0; m < 4; ++m)
#pragma unroll
                for (int bj = 0; bj < 2; ++bj) { const u32x4 w = __builtin_nontemporal_load((const u32x4*)(base + (size_t)(ai * 128 + m * 16) * DM + bj * 128));
                    acc[ai][bj][m][0] *= (f32x4){bf_lo(w.x), bf_hi(w.x), bf_lo(w.y), bf_hi(w.y)}; acc[ai][bj][m][1] *= (f32x4){bf_lo(w.z), bf_hi(w.z), bf_lo(w.w), bf_hi(w.w)}; }
    }
    __device__ __forceinline__ void operator()(const Acc& acc, const Unit& u, int wr, int wc, int fr, int fq) const {
        const size_t o0 = (size_t)(u.pm * 256 + wr * 64 + fr) * DM + u.pn * 256 + wc * 32 + 8 * fq;
#pragma unroll
        for (int ai = 0; ai < 2; ++ai)
#pragma unroll
            for (int m = 0; m < 4; ++m)
#pragma unroll
                for (int bj = 0; bj < 2; ++bj) { const size_t o = o0 + (size_t)(ai * 128 + m * 16) * DM + bj * 128; const u32x4 w = __builtin_nontemporal_load((const u32x4*)(S2 + o));
                    const f32x4 v0 = acc[ai][bj][m][0] * (f32x4){bf_lo(w.x), bf_hi(w.x), bf_lo(w.y), bf_hi(w.y)}, v1 = acc[ai][bj][m][1] * (f32x4){bf_lo(w.z), bf_hi(w.z), bf_lo(w.w), bf_hi(w.w)};
                    *(u32x4*)(MG + o) = pack8(v0, v1); }
    }
};

struct EpiOut {
    static constexpr bool PERM = false;
    const float* x; float* out; float* SS;
    __device__ __forceinline__ void mid(Acc&, const Unit&, int, int, int, int) const {}
    __device__ __forceinline__ void operator()(const Acc& acc, const Unit& u, int wr, int wc, int fr, int fq) const {
        const size_t o0 = (size_t)(u.pm * 256 + wr * 64 + fr) * DM + u.pn * 256 + wc * 32 + 4 * fq;
#pragma unroll
        for (int ai = 0; ai < 2; ++ai)
#pragma unroll
            for (int m = 0; m < 4; ++m) { float s = 0.f; const size_t o = o0 + (size_t)(ai * 128 + m * 16) * DM;
#pragma unroll
                for (int bj = 0; bj < 2; ++bj)
#pragma unroll
                    for (int n = 0; n < 2; ++n) { const f32x4 y = *(const f32x4*)(x + o + bj * 128 + n * 16) + acc[ai][bj][m][n];
                        s += (y[0] * y[0] + y[1] * y[1]) + (y[2] * y[2] + y[3] * y[3]); *(f32x4*)(out + o + bj * 128 + n * 16) = y; }
                s += __shfl_xor(s, 16); s += __shfl_xor(s, 32);
                if (fq == 0) SS[(size_t)(u.pm * 256 + wr * 64 + fr + ai * 128 + m * 16) * 32 + u.pn * 4 + wc] = s; }
    }
};
struct EpiOutNorm {
    static constexpr bool PERM = false;
    const float* x; float* out; const float* gain; float* xbuf; unsigned* cnt;
    __device__ __forceinline__ void mid(Acc&, const Unit&, int, int, int, int) const {}
    __device__ __forceinline__ void operator()(const Acc&, const Unit&, int, int, int, int) const {}
    __device__ __forceinline__ void fused(Acc& acc, const Unit& u, int wr, int wc, int fr, int fq, LAS unsigned char* lds, int wid, int lane) const {
        LAS float* P = (LAS float*)lds;
        LAS float* S = (LAS float*)(lds + 8192);
        const size_t o0 = (size_t)(u.pm * 256 + wr * 64 + fr) * DM + u.pn * 256 + wc * 32 + 4 * fq;
#pragma unroll
        for (int ai = 0; ai < 2; ++ai)
#pragma unroll
            for (int m = 0; m < 4; ++m) { float s = 0.f; const size_t o = o0 + (size_t)(ai * 128 + m * 16) * DM;
#pragma unroll
                for (int bj = 0; bj < 2; ++bj)
#pragma unroll
                    for (int n = 0; n < 2; ++n) { const f32x4 y = __builtin_nontemporal_load((const f32x4*)(x + o + bj * 128 + n * 16)) + acc[ai][bj][m][n]; acc[ai][bj][m][n] = y;
                        s += (y[0] * y[0] + y[1] * y[1]) + (y[2] * y[2] + y[3] * y[3]); }
                s += __shfl_xor(s, 16); s += __shfl_xor(s, 32);
                if (fq == 0) P[(ai * 128 + wr * 64 + m * 16 + fr) * 4 + wc] = s; }
        asm volatile("s_waitcnt lgkmcnt(0)" ::: "memory"); __builtin_amdgcn_s_barrier(); asm volatile("" ::: "memory");
        const int row = wid * 32 + (lane & 31);
        if (lane < 32) { const float t = (P[row * 4 + 0] + P[row * 4 + 1]) + (P[row * 4 + 2] + P[row * 4 + 3]);
            __hip_atomic_store(xbuf + (size_t)(u.pm * 256 + row) * 8 + u.pn, t, __ATOMIC_RELAXED, __HIP_MEMORY_SCOPE_AGENT); }
        asm volatile("s_waitcnt vmcnt(0)" ::: "memory");
        if (lane == 0) __hip_atomic_fetch_add(cnt + 64 * u.pm, 1u, __ATOMIC_RELAXED, __HIP_MEMORY_SCOPE_AGENT);
        if (wid == 0) {
            while ((unsigned)__builtin_amdgcn_readfirstlane(__hip_atomic_load(cnt + 64 * u.pm, __ATOMIC_RELAXED, __HIP_MEMORY_SCOPE_AGENT)) < 64u) __builtin_amdgcn_s_sleep(2);
            __builtin_amdgcn_fence(__ATOMIC_ACQUIRE, "agent");
        }
        asm volatile("s_waitcnt vmcnt(0) lgkmcnt(0)" ::: "memory"); __builtin_amdgcn_s_barrier(); asm volatile("" ::: "memory");
        if (lane < 32) { const float* slot = xbuf + (size_t)(u.pm * 256 + row) * 8; float t = 0.f;
#pragma unroll
            for (int k = 0; k < 8; ++k) t += __hip_atomic_load(slot + k, __ATOMIC_RELAXED, __HIP_MEMORY_SCOPE_AGENT);
            S[row] = 1.0f / sqrtf(t * (1.f / DM) + EPS); }
        asm volatile("s_waitcnt lgkmcnt(0)" ::: "memory"); __builtin_amdgcn_s_barrier(); asm volatile("" ::: "memory");
        const int c0 = u.pn * 256 + wc * 32 + 4 * fq;
#pragma unroll
        for (int bj = 0; bj < 2; ++bj)
#pragma unroll
            for (int n = 0; n < 2; ++n) { const f32x4 g = *(const f32x4*)(gain + c0 + bj * 128 + n * 16);
#pragma unroll
                for (int ai = 0; ai < 2; ++ai)
#pragma unroll
                    for (int m = 0; m < 4; ++m) { const int r = ai * 128 + wr * 64 + m * 16 + fr;
                        __builtin_nontemporal_store(acc[ai][bj][m][n] * S[r] * g, (f32x4*)(out + (size_t)(u.pm * 256 + r) * DM + c0 + bj * 128 + n * 16)); } }
    }
};
}

namespace att {
constexpr int D = 128, LD = DM, NW = 8, QBLK = 32, KVBLK = 64, QB = 256;
constexpr int SHM_V = KVBLK * D * 2, SHM_K = KVBLK * D * 2;
constexpr int NSLOT = 3, SLOT = SHM_V, OFF_K = NSLOT * SHM_V;
constexpr int OFF_WS = NSLOT * (SHM_V + SHM_K), OFF_C = OFF_WS + NW * 64 * 4, OFF_RED = OFF_C + KVROWS * 4, LDS_BYTES = OFF_RED + 64;
constexpr float THR2 = 11.5f;
#define KSWZ(row, colB) ((row) * 256 + ((colB) ^ (((row) & 7) << 4)))
#define SBAR() __builtin_amdgcn_sched_barrier(0)
__device__ __forceinline__ int v_st(int k, int c) { const int kk = (k & ~0xC) | ((k & 4) << 1) | ((k & 8) >> 1); return ((kk >> 3) * 4 + (c >> 5)) * 512 + ((kk & 7) * 32 + (c & 31)) * 2; }
__device__ __forceinline__ int v_rd_base(int lane) { return ((lane & 3) << 3) | (((lane >> 2) & 3) << 6) | (((lane >> 4) & 1) << 5) | (((lane >> 5) & 1) << 8); }
constexpr int v_rd_off(int d0, int ks, int half) { return d0 * 512 + ks * 4096 + half * 2048; }
__device__ __forceinline__ int crow(int r, int hi) { return (r & 3) + 8 * (r >> 2) + 4 * hi; }
__device__ __forceinline__ bf16x8 load8(const bf16_t* p) { return *reinterpret_cast<const bf16x8*>(p); }

__device__ __forceinline__ void mask_tile(f32x16& p0, f32x16& p1, int dq) {
    const float NEG = -__builtin_inff();
#pragma unroll
    for (int r = 0; r < 16; ++r) { const int c = (r & 3) + 8 * (r >> 2); if (dq - c < 0) p0[r] = NEG; if (dq - c - 32 < 0) p1[r] = NEG; }
}
__device__ __forceinline__ void mask_meta(f32x16& p0, f32x16& p1) {
    const float NEG = -__builtin_inff();
#pragma unroll
    for (int r = 0; r < 16; ++r) { p0[r] = NEG; if (r < 8) p1[r] = NEG; }
}
__device__ __forceinline__ void partialSM(f32x16& p0, f32x16& p1, float& m_reg, float& mn, float& alpha) {
    float pmax = p0[0];
#pragma unroll
    for (int r = 1; r < 16; ++r) pmax = fmaxf(pmax, p0[r]);
#pragma unroll
    for (int r = 0; r < 16; ++r) pmax = fmaxf(pmax, p1[r]);
    { auto rr = __builtin_amdgcn_permlane32_swap(__float_as_uint(pmax), __float_as_uint(pmax), false, false);
      pmax = fmaxf(__uint_as_float(rr[0]), __uint_as_float(rr[1])); }
    if (__builtin_expect(__all((pmax - m_reg) <= THR2), 1)) { mn = m_reg; alpha = 1.f; }
    else { mn = fmaxf(m_reg, pmax); alpha = __builtin_amdgcn_exp2f(m_reg - mn); m_reg = mn; }
#pragma unroll
    for (int r = 0; r < 16; ++r) p0[r] = p0[r] - mn;
#pragma unroll
    for (int r = 0; r < 16; ++r) p1[r] = p1[r] - mn;
#pragma unroll
    for (int r = 0; r < 16; ++r) p0[r] = __builtin_amdgcn_exp2f(p0[r]);
}
__device__ __forceinline__ void finishSM(f32x16& p0, f32x16& p1, float alpha, float& l_reg, bf16x8& pa0, bf16x8& pa1, bf16x8& pa2, bf16x8& pa3) {
#pragma unroll
    for (int r = 0; r < 16; ++r) p1[r] = __builtin_amdgcn_exp2f(p1[r]);
    float ps = 0;
#pragma unroll
    for (int r = 0; r < 16; ++r) ps += p0[r];
#pragma unroll
    for (int r = 0; r < 16; ++r) ps += p1[r];
    { auto rr = __builtin_amdgcn_permlane32_swap(__float_as_uint(ps), __float_as_uint(ps), false, false);
      ps = __uint_as_float(rr[0]) + __uint_as_float(rr[1]); }
    l_reg = l_reg * alpha + ps;
#define PK4(P, B_, OUT) do { unsigned a0 = cvt_pk_bf16(P[B_+0], P[B_+1]), a1 = cvt_pk_bf16(P[B_+2], P[B_+3]);                          \
        unsigned b0 = cvt_pk_bf16(P[B_+4], P[B_+5]), b1 = cvt_pk_bf16(P[B_+6], P[B_+7]);                                             \
        auto r0 = __builtin_amdgcn_permlane32_swap(a0, b0, false, false); auto r1 = __builtin_amdgcn_permlane32_swap(a1, b1, false, false); \
        u32x4 w = {r0[0], r1[0], r0[1], r1[1]}; OUT = *reinterpret_cast<bf16x8*>(&w); } while (0)
    PK4(p0, 0, pa0); PK4(p0, 8, pa1); PK4(p1, 0, pa2); PK4(p1, 8, pa3);
#undef PK4
}
__device__ __forceinline__ void qkt(f32x16& p0, f32x16& p1, const char* Kslot, int r32, int hi, const bf16x8* qr, const LAS f32x4* cp) {
#pragma unroll
    for (int g = 0; g < 4; ++g) { const f32x4 c0 = cp[2 * g], c1 = cp[8 + 2 * g];
#pragma unroll
        for (int j = 0; j < 4; ++j) { p0[4 * g + j] = c0[j]; p1[4 * g + j] = c1[j]; } }
    const char* kb[4];
#pragma unroll
    for (int dd = 0; dd < 4; ++dd) kb[dd] = Kslot + KSWZ(r32, (dd * 16 + hi * 8) * 2);
#pragma unroll
    for (int d0 = 0; d0 < 8; ++d0) { const char* a = kb[d0 & 3] + (d0 >> 2) * 128;
        bf16x8 b0 = *reinterpret_cast<const bf16x8*>(a);
        bf16x8 b1 = *reinterpret_cast<const bf16x8*>(a + 32 * 256);
        p0 = __builtin_amdgcn_mfma_f32_32x32x16_bf16(b0, qr[d0], p0, 0, 0, 0);
        p1 = __builtin_amdgcn_mfma_f32_32x32x16_bf16(b1, qr[d0], p1, 0, 0, 0); }
}
__device__ __forceinline__ void pv_tile(f32x16* o, int vb0, bf16x8 pa0, bf16x8 pa1, bf16x8 pa2, bf16x8 pa3) {
#define TRRD(dst, off) asm volatile("ds_read_b64_tr_b16 %0, %1 offset:%2" : "=&v"(dst) : "v"(vb0), "i"(off) : "memory")
#define PV_RD(d0, kh, X) do { constexpr int b_ = v_rd_off(d0, 2 * (kh), 0); TRRD(X##l0, b_); TRRD(X##h0, b_ + 2048); TRRD(X##l1, b_ + 4096); TRRD(X##h1, b_ + 6144); } while (0)
#define PV_MM(d0, X, PA, PB) do { \
        o[d0] = __builtin_amdgcn_mfma_f32_32x32x16_bf16(PA, (bf16x8){X##l0[0], X##l0[1], X##l0[2], X##l0[3], X##h0[0], X##h0[1], X##h0[2], X##h0[3]}, o[d0], 0, 0, 0);   \
        o[d0] = __builtin_amdgcn_mfma_f32_32x32x16_bf16(PB, (bf16x8){X##l1[0], X##l1[1], X##l1[2], X##l1[3], X##h1[0], X##h1[1], X##h1[2], X##h1[3]}, o[d0], 0, 0, 0); } while (0)
#define PV_W4() do { asm volatile("s_waitcnt lgkmcnt(4)" ::: "memory"); SBAR(); } while (0)
#define PV_W0() do { asm volatile("s_waitcnt lgkmcnt(0)" ::: "memory"); SBAR(); } while (0)
    s16x4 al0, al1, ah0, ah1, bl0, bl1, bh0, bh1;
    PV_RD(0, 0, a);
    PV_RD(0, 1, b); PV_W4(); PV_MM(0, a, pa0, pa1); SBAR();
    PV_RD(1, 0, a); PV_W4(); PV_MM(0, b, pa2, pa3); SBAR();
    PV_RD(1, 1, b); PV_W4(); PV_MM(1, a, pa0, pa1); SBAR();
    PV_RD(2, 0, a); PV_W4(); PV_MM(1, b, pa2, pa3); SBAR();
    PV_RD(2, 1, b); PV_W4(); PV_MM(2, a, pa0, pa1); SBAR();
    PV_RD(3, 0, a); PV_W4(); PV_MM(2, b, pa2, pa3); SBAR();
    PV_RD(3, 1, b); PV_W4(); PV_MM(3, a, pa0, pa1); SBAR();
    PV_W0(); PV_MM(3, b, pa2, pa3);
#undef PV_RD
#undef PV_MM
#undef PV_W4
#undef PV_W0
#undef TRRD
}

struct BlockRef { const bf16_t* Q; const bf16_t* K; const bf16_t* V; const bf16_t* Z; bf16_t* O; int P0; };
struct Seam { bf16x8 qr[8]; };
#define WAITV_BAR(N) asm volatile("s_waitcnt vmcnt(" #N ") lgkmcnt(0)\n\ts_barrier" ::: "memory")
struct DmaOff { unsigned k[2], v[2]; };
__device__ __forceinline__ DmaOff dma_offsets(int wid, int lane) {
    DmaOff d;
#pragma unroll
    for (int i = 0; i < 2; ++i) { const int pc = wid * 2 + i, q = pc * 64 + lane;
        const int row = q >> 4, j = (q & 15) ^ (row & 7); d.k[i] = (unsigned)(row * 256 + j * 16);
        const int s = q >> 5, w = q & 31, kk = (s >> 2) * 8 + (w >> 2), c = (s & 3) * 32 + (w & 3) * 8, k = (kk & ~0xC) | ((kk & 4) << 1) | ((kk & 8) >> 1);
        d.v[i] = (unsigned)(k * 256 + c * 2); }
    return d;
}
#define DMA_K(t, slot) do { _Pragma("unroll") for (int i_ = 0; i_ < 2; ++i_) __builtin_amdgcn_global_load_lds((const unsigned*)((const char*)Kh + (size_t)(t) * (KVBLK * D * 2) + dof.k[i_]), \
        (LAS unsigned*)((LAS unsigned char*)lds3 + OFF_K + (slot) + (wid * 2 + i_) * 1024), 16, 0, 0); } while (0)
#define DMA_V(t, slot) do { _Pragma("unroll") for (int i_ = 0; i_ < 2; ++i_) __builtin_amdgcn_global_load_lds((const unsigned*)((const char*)Vh + (size_t)(t) * (KVBLK * D * 2) + dof.v[i_]), \
        (LAS unsigned*)((LAS unsigned char*)lds3 + (slot) + (wid * 2 + i_) * 1024), 16, 0, 0); } while (0)
__device__ __forceinline__ void fox_prime(const BlockRef& cur, char* lds, Seam& S, const int tid) {
    const int wid = __builtin_amdgcn_readfirstlane(tid >> 6), lane = tid & 63, r32 = lane & 31, hi = lane >> 5;
    LAS unsigned char* lds3 = (LAS unsigned char*)lds; const DmaOff dof = dma_offsets(wid, lane);
    const bf16_t* Kh = cur.K; const bf16_t* Vh = cur.V;
#pragma unroll
    for (int d0 = 0; d0 < 8; ++d0) S.qr[d0] = load8(cur.Q + (size_t)(wid * QBLK + r32) * LD + d0 * 16 + hi * 8);
    SBAR(); DMA_K(0, 0); DMA_K(1, SLOT); DMA_V(0, 0); SBAR();
    WAITV_BAR(0);
}
__device__ __forceinline__ void fox_block(const BlockRef& cur, const BlockRef& nxt, char* lds, Seam& S, const int tid) {
    const int wid = __builtin_amdgcn_readfirstlane(tid >> 6), lane = tid & 63, r32 = lane & 31, hi = lane >> 5;
    const int NT = cur.P0 / KVBLK + 4;
    const int qlo = cur.P0 + wid * QBLK, qm = qlo + r32 - 4 * hi;
    char* V_lds = lds; char* K_lds = lds + OFF_K; LAS unsigned char* lds3 = (LAS unsigned char*)lds;
    float* ws = (float*)(lds + OFF_WS) + wid * 64; float* li_l = ws, * al_l = ws + 32;
    const LAS float* ctab = (const LAS float*)(LAS char*)(lds + OFF_C);
    float m_reg = -1e30f, l_reg = 0; f32x16 o[4] = {};
    const DmaOff dof = dma_offsets(wid, lane);
    const int vb0 = (int)(uintptr_t)V_lds + v_rd_base(lane);
    const bf16_t* Kh = cur.K; const bf16_t* Vh = cur.V;
#define RESC(a) do { if (__any((a) < 1.f)) { if (hi == 0) al_l[r32] = (a); asm volatile("s_waitcnt lgkmcnt(0)" ::: "memory");              \
                     for (int d_ = 0; d_ < 4; ++d_) for (int r = 0; r < 16; ++r) o[d_][r] *= al_l[crow(r, hi)]; } } while (0)
#define MASKT(P0_, P1_, t) do { const int kb_ = (t) * KVBLK; if (kb_ + KVBLK - 1 > qlo) mask_tile(P0_, P1_, qm - kb_); } while (0)
#define CTP(t) ((const LAS f32x4*)(ctab + (t) * KVBLK + 4 * hi))
#define ROT() do { s_prev = s_cur; s_cur = s_next; s_next = s_nn; s_nn = (s_nn == (NSLOT - 1) * SLOT) ? 0 : s_nn + SLOT; } while (0)
#define ENDW(t) do { if ((t) + 2 < NT) { WAITV_BAR(4); } else if ((t) + 1 < NT) { WAITV_BAR(2); } else { WAITV_BAR(0); } } while (0)
    f32x16 pA0, pA1, pB0, pB1; float mnA, mnB, alA, alB; bf16x8 pa0, pa1, pa2, pa3;
    int s_prev = 0, s_cur = 0, s_next = SLOT, s_nn = 2 * SLOT;
    SBAR(); DMA_K(2, s_nn); DMA_V(1, s_next); SBAR();
    qkt(pA0, pA1, K_lds + s_cur, r32, hi, S.qr, CTP(0));
    mask_meta(pA0, pA1); partialSM(pA0, pA1, m_reg, mnA, alA);
    SBAR(); WAITV_BAR(4);
    ROT();
#define STEP(PX0, PX1, mnX, alX, PY0, PY1, alY, t) do {                                                                       \
        SBAR(); if ((t) + 2 < NT) { DMA_K((t) + 2, s_nn); } if ((t) + 1 < NT) { DMA_V((t) + 1, s_next); }                     \
        SBAR(); qkt(PX0, PX1, K_lds + s_cur, r32, hi, S.qr, CTP(t));                                                          \
        finishSM(PY0, PY1, alY, l_reg, pa0, pa1, pa2, pa3); SBAR();                                                           \
        pv_tile(o, vb0 + s_prev, pa0, pa1, pa2, pa3); MASKT(PX0, PX1, (t)); partialSM(PX0, PX1, m_reg, mnX, alX);             \
        RESC(alX);                                                                                                            \
        SBAR(); ENDW(t);                                                                                                      \
        ROT(); } while (0)
    for (int t = 1; t + 1 < NT; t += 2) {
        STEP(pB0, pB1, mnB, alB, pA0, pA1, alA, t);
        STEP(pA0, pA1, mnA, alA, pB0, pB1, alB, t + 1);
    }
    finishSM(pA0, pA1, alA, l_reg, pa0, pa1, pa2, pa3); SBAR();
    pv_tile(o, vb0 + s_prev, pa0, pa1, pa2, pa3);
    SBAR(); WAITV_BAR(0);
    { const bf16_t* Kh = nxt.K; const bf16_t* Vh = nxt.V;
#pragma unroll
      for (int d0 = 0; d0 < 8; ++d0) S.qr[d0] = load8(nxt.Q + (size_t)(wid * QBLK + r32) * LD + d0 * 16 + hi * 8);
      SBAR(); DMA_K(0, 0); DMA_K(1, SLOT); DMA_V(0, 0); SBAR(); }
    if (hi == 0) li_l[r32] = l_reg; asm volatile("s_waitcnt lgkmcnt(0)" ::: "memory");
    float rli[16];
#pragma unroll
    for (int r = 0; r < 16; ++r) rli[r] = __builtin_amdgcn_rcpf(li_l[crow(r, hi)]);
    typedef __attribute__((address_space(1))) bf16_t gbf16; typedef __attribute__((address_space(1))) u32x4 gu32x4;
    LAS float* stg = (LAS float*)(lds3 + SLOT + wid * 4096);
    const int er = lane >> 2, eq = lane & 3;
    gbf16* obase = (gbf16*)(cur.O + (size_t)(wid * QBLK + er) * LD + 8 * eq); const gbf16* zbase = (const gbf16*)(cur.Z + (size_t)(wid * QBLK + er) * LD + 8 * eq);
#pragma unroll
    for (int d0 = 0; d0 < 4; ++d0) {
#pragma unroll
        for (int r = 0; r < 16; ++r) stg[crow(r, hi) * 32 + r32] = o[d0][r] * rli[r];
        asm volatile("s_waitcnt lgkmcnt(0)" ::: "memory");
        gbf16* op = obase; const gbf16* zp = zbase;
#pragma unroll
        for (int i = 0; i < 2; ++i) {
            asm volatile("" : "+v"(op), "+v"(zp));
            const f32x4 v0 = *(const LAS f32x4*)(stg + (er + 16 * i) * 32 + 8 * eq), v1 = *(const LAS f32x4*)(stg + (er + 16 * i) * 32 + 8 * eq + 4);
            const u32x4 z = __builtin_nontemporal_load((const gu32x4*)(zp + d0 * 32));
            u32x4 w; w.x = cvt_pk_bf16(v0.x * bf_lo(z.x), v0.y * bf_hi(z.x)); w.y = cvt_pk_bf16(v0.z * bf_lo(z.y), v0.w * bf_hi(z.y));
            w.z = cvt_pk_bf16(v1.x * bf_lo(z.z), v1.y * bf_hi(z.z)); w.w = cvt_pk_bf16(v1.z * bf_lo(z.w), v1.w * bf_hi(z.w));
            *(gu32x4*)(op + d0 * 32) = w;
            op += 16 * LD; zp += 16 * LD; }
        asm volatile("s_waitcnt lgkmcnt(0)" ::: "memory"); }
    WAITV_BAR(0);
#undef RESC
#undef MASKT
#undef CTP
#undef ROT
#undef ENDW
#undef STEP
}
#undef DMA_K
#undef DMA_V
#undef WAITV_BAR
#undef ROWP
#undef VMW
#undef VMWN
#undef SLOAD_H
#undef SWRITE_H
__device__ __forceinline__ void build_ctab(char* lds, const float* LFbh, const int tid) {
    const int lane = tid & 63, wid = tid >> 6;
    float* ctab = (float*)(lds + OFF_C); float* red = (float*)(lds + OFF_RED);
    constexpr int PER = 9; const int e0 = tid * PER;
    float v[PER]; float s = 0.f;
#pragma unroll
    for (int i = 0; i < PER; ++i) { const int kk = e0 + i; float x = 0.f; if (kk >= 48 && kk < KVROWS) x = LFbh[kk]; s += x; v[i] = s; }
    float incl = s;
#pragma unroll
    for (int off = 1; off < 64; off <<= 1) { const float t = __shfl_up(incl, off); if (lane >= off) incl += t; }
    if (lane == 63) red[wid] = incl;
    __syncthreads();
    float base = incl - s;
    for (int w = 0; w < wid; ++w) base += red[w];
#pragma unroll
    for (int i = 0; i < PER; ++i) { const int kk = e0 + i; if (kk < KVROWS) ctab[kk] = -(base + v[i]); }
    __syncthreads();
}
struct Tensors { const bf16_t* Q; const bf16_t* K; const bf16_t* V; const bf16_t* Z; bf16_t* O; const float* LF; };
__device__ __forceinline__ BlockRef mkref(const Tensors& T, int b, int h, int qb) {
    BlockRef r; const size_t qo = (size_t)(b * SEQ + qb * QB) * LD + h * D, ko = (size_t)(b * NH + h) * KVROWS * D;
    r.Q = T.Q + qo; r.Z = T.Z + qo; r.O = T.O + qo; r.K = T.K + ko; r.V = T.V + ko; r.P0 = 64 + qb * QB; return r;
}
__device__ __forceinline__ void attn_phase(char* lds, const Tensors& T, int vcu, int G) {
    for (int L = vcu; L < NB * NH * 8; L += G) {
        const int bh = L >> 3, x = L & 7, b = bh >> 4, h = bh & 15;
        int tid = threadIdx.x; asm volatile("" : "+v"(tid));
        build_ctab(lds, T.LF + (size_t)(b * NH + h) * KVROWS, tid);
        const BlockRef r0 = mkref(T, b, h, 15 - x), r1 = mkref(T, b, h, x);
        Seam S;
        fox_prime(r0, lds, S, tid);
        fox_block(r0, r1, lds, S, tid);
        fox_block(r1, r1, lds, S, tid);
    }
}
#undef SBAR
#undef KSWZ
}

constexpr int NWAVES = 8, NTHREADS = 512;
constexpr int LDS_BYTES = 147456;
static_assert(att::LDS_BYTES <= 131072 && pg8::STAGE_BYTES <= 131072, "LDS map");

struct Args { const float* in[10]; float* out; unsigned char* ws; int ph_lo, ph_hi; };

__device__ __forceinline__ unsigned f2bf(float f) { unsigned u = __builtin_bit_cast(unsigned, f); return (u + 0x7fffu + ((u >> 16) & 1u)) >> 16; }
__device__ __forceinline__ unsigned pk2(float lo, float hi) { return cvt_pk_bf16(lo, hi); }
__device__ __forceinline__ float wave_sum(float v) {
#pragma unroll
    for (int o = 1; o < 64; o <<= 1) v += __shfl_xor(v, o);
    return v;
}
__device__ __forceinline__ int src_col_of_dst(int r0) {
    if (r0 < 6144) return r0;
    if (r0 < 8192) return r0 + 16;
    if (r0 < 12288) { const int p = (r0 - 8192) >> 8, w = (r0 - 8192) & 255; return (w < 128 ? 8208 : 12304) + 128 * p + (w & 127); }
    if (r0 < 16384) { const int p = (r0 - 12288) >> 8, w = (r0 - 12288) & 255; return (w < 128 ? 10256 : 14352) + 128 * p + (w & 127); }
    if (r0 < 20480) { const int p = (r0 - 16384) >> 8, w = (r0 - 16384) & 255; return (w < 128 ? 16400 : 18448) + 128 * p + (w & 127); }
    return 6144;
}
struct TrItem { const float* src; bf16_t* dst; int ldn, nvalid4; };
__device__ __forceinline__ void tr_load(f32x4 (&v)[16], const TrItem& t, int lane) {
    const int ks = lane >> 4, g = lane & 15;
#pragma unroll
    for (int i = 0; i < 16; ++i) v[i] = (g < t.nvalid4) ? __builtin_nontemporal_load((const f32x4*)(t.src + (size_t)(4 * i + ks) * t.ldn + 4 * g)) : (f32x4){0.f, 0.f, 0.f, 0.f};
}
__device__ __forceinline__ void tr_process(const f32x4 (&v)[16], const TrItem& t, LAS float* scr, int lane) {
    const int ks = lane >> 4, g = lane & 15;
#pragma unroll
    for (int i = 0; i < 16; ++i) { LAS float* w = scr + (4 * i + ks) * 65 + 4 * g; w[0] = v[i].x; w[1] = v[i].y; w[2] = v[i].z; w[3] = v[i].w; }
    asm volatile("s_waitcnt lgkmcnt(0)" ::: "memory");
    const int c = lane & 7;
#pragma unroll
    for (int j = 0; j < 8; ++j) { const int n = (lane >> 3) + 8 * j; const LAS float* s = scr + (8 * c) * 65 + n;
        u32x4 o; o.x = pk2(s[0 * 65], s[1 * 65]); o.y = pk2(s[2 * 65], s[3 * 65]); o.z = pk2(s[4 * 65], s[5 * 65]); o.w = pk2(s[6 * 65], s[7 * 65]);
        if (n < 4 * t.nvalid4 || t.nvalid4 == 16) *(u32x4*)(t.dst + (size_t)n * 2048 + 8 * c) = o; }
    asm volatile("s_waitcnt lgkmcnt(0)" ::: "memory");
}
__device__ __forceinline__ void rms_rows2_to_bf16(const float* xa, bf16_t* oa, const float* xb, bf16_t* ob, bool hasb, const float* gain, int lane) {
    const f32x4* ra = (const f32x4*)xa + lane; const f32x4* rb = (const f32x4*)(hasb ? xb : xa) + lane; const f32x4* gr = (const f32x4*)gain + lane;
    f32x4 v[8], w[8]; float s = 0.f, s2 = 0.f;
#pragma unroll
    for (int j = 0; j < 8; ++j) v[j] = __builtin_nontemporal_load(ra + 64 * j);
#pragma unroll
    for (int j = 0; j < 8; ++j) w[j] = __builtin_nontemporal_load(rb + 64 * j);
#pragma unroll
    for (int j = 0; j < 8; ++j) { s += (v[j].x * v[j].x + v[j].y * v[j].y) + (v[j].z * v[j].z + v[j].w * v[j].w); s2 += (w[j].x * w[j].x + w[j].y * w[j].y) + (w[j].z * w[j].z + w[j].w * w[j].w); }
    const float rstd = 1.0f / sqrtf(wave_sum(s) * (1.f / DM) + EPS), rstd2 = 1.0f / sqrtf(wave_sum(s2) * (1.f / DM) + EPS);
    unsigned long long* o8 = (unsigned long long*)oa + lane; unsigned long long* p8 = (unsigned long long*)ob + lane;
#pragma unroll
    for (int j = 0; j < 8; ++j) { const f32x4 g = gr[64 * j]; const f32x4 y = v[j] * rstd * g, z = w[j] * rstd2 * g;
        o8[64 * j] = (unsigned long long)pk2(y.x, y.y) | ((unsigned long long)pk2(y.z, y.w) << 32);
        if (hasb) p8[64 * j] = (unsigned long long)pk2(z.x, z.y) | ((unsigned long long)pk2(z.z, z.w) << 32); }
}
__device__ __forceinline__ void zero_bytes16(void* p, size_t nbytes, int gt, int ngt) {
    u32x4* q = (u32x4*)p; const size_t n = nbytes / 16;
    for (size_t i = gt; i < n; i += ngt) q[i] = (u32x4){0u, 0u, 0u, 0u};
}

__device__ __forceinline__ void p1_side_task(int c, LAS unsigned char* lds, const bf16_t* XN, const bf16_t* WIN, const float* b_f, float* LF, bf16_t* Kb, bf16_t* Vb, bf16_t* P1b) {
    const int tid = threadIdx.x, lane = tid & 63, w = __builtin_amdgcn_readfirstlane(tid >> 6), fr = lane & 15, fq = lane >> 4;
    const bf16_t* XM = XN + (size_t)MREAL * DM;
    const bf16_t* WF = WIN + (size_t)20480 * DM;
    int n0, n1;
    if (c < 64) { n0 = 2048 + 32 * c; n1 = n0 + 16; } else if (c < 128) { n0 = 4096 + 32 * (c - 64); n1 = n0 + 16; }
    else { const int ch0 = 16 * (c - 128); n0 = 8192 + 256 * (ch0 >> 7) + (ch0 & 127); n1 = n0 + 128; }
    const size_t lo_ = (size_t)fr * DM + 256 * w + 8 * fq;
    const bf16_t* P6[6] = {XN + (size_t)(32 * c) * DM + lo_, XN + (size_t)(32 * c + 16) * DM + lo_, XM + lo_, WF + lo_, WIN + (size_t)n0 * DM + lo_, WIN + (size_t)n1 * DM + lo_};
    bf16x8 fr6[6][8];
#pragma unroll
    for (int s = 0; s < 6; ++s)
#pragma unroll
        for (int i = 0; i < 8; ++i) fr6[s][i] = *(const bf16x8*)(P6[s] + 32 * i);
    f32x4 acc[5];
#pragma unroll
    for (int g = 0; g < 5; ++g) acc[g] = (f32x4){0.f, 0.f, 0.f, 0.f};
#pragma unroll
    for (int i = 0; i < 8; ++i) {
        acc[0] = __builtin_amdgcn_mfma_f32_16x16x32_bf16(fr6[0][i], fr6[3][i], acc[0], 0, 0, 0);
        acc[1] = __builtin_amdgcn_mfma_f32_16x16x32_bf16(fr6[1][i], fr6[3][i], acc[1], 0, 0, 0);
        acc[2] = __builtin_amdgcn_mfma_f32_16x16x32_bf16(fr6[2][i], fr6[3][i], acc[2], 0, 0, 0);
        acc[3] = __builtin_amdgcn_mfma_f32_16x16x32_bf16(fr6[4][i], fr6[2][i], acc[3], 0, 0, 0);
        acc[4] = __builtin_amdgcn_mfma_f32_16x16x32_bf16(fr6[5][i], fr6[2][i], acc[4], 0, 0, 0);
    }
    LAS f32x4* red = (LAS f32x4*)lds;
#pragma unroll
    for (int g = 0; g < 5; ++g) red[(w * 5 + g) * 64 + lane] = acc[g];
    __syncthreads();
    if (w == 0) {
#pragma unroll
        for (int g = 0; g < 5; ++g) { f32x4 s = red[g * 64 + lane];
#pragma unroll
            for (int ww = 1; ww < 8; ++ww) s += red[(ww * 5 + g) * 64 + lane];
            acc[g] = s; }
        const float bfh = b_f[fr];
#pragma unroll
        for (int g = 0; g < 3; ++g)
#pragma unroll
            for (int j = 0; j < 4; ++j) { const float xx = acc[g][j] + bfh; const float v = (fminf(xx, 0.f) - log1pf(__expf(-fabsf(xx)))) * LOG2E; const int m = 4 * fq + j;
                if (g < 2) { const int row = 32 * c + 16 * g + m; LF[(size_t)((row >> 12) * NH + fr) * KVROWS + 64 + (row & 4095)] = v; }
                else if (c == 0) { LF[(size_t)fr * KVROWS + 48 + m] = v; LF[(size_t)(NH + fr) * KVROWS + 48 + m] = v; } }
        if (c < 128) {
            bf16_t* T = (c < 64) ? Kb : Vb; const int col0 = (c < 64) ? 32 * c : 32 * (c - 64);
#pragma unroll
            for (int g = 0; g < 2; ++g)
#pragma unroll
                for (int j = 0; j < 4; ++j) { const bf16_t v = (bf16_t)(cvt_pk_bf16(acc[3 + g][j], 0.f) & 0xffffu); const int col = col0 + 16 * g + 4 * fq + j;
                    const size_t o_ = ((size_t)(col >> 7) * KVROWS + 48 + fr) * HD + (col & 127); T[o_] = v; T[o_ + (size_t)NH * KVROWS * HD] = v; }
        } else if (fr >= 14) {
            const int ch0 = 16 * (c - 128);
#pragma unroll
            for (int j = 0; j < 4; ++j) { const bf16_t v = (bf16_t)(cvt_pk_bf16(acc[3][j] * acc[4][j], 0.f) & 0xffffu); const int col = ch0 + 4 * fq + j;
                P1b[(size_t)(fr - 14) * DM + col] = v; P1b[(size_t)(P1ROWS + fr - 14) * DM + col] = v; }
        }
    }
    __syncthreads();
}

#define XB_TMO      128
#define XB_XCNT(j)  (256  + 64 * (j))
#define XB_XSUB(j)  (1280 + 64 * (j))
#define XB_XGEN(j)  (2304 + 64 * (j))
#define XB_TOP      3328
#define XB_TOPGEN   3392
#define XCD_BAR_WORDS 3456
#define XB_SPIN_CAP (1u << 22)
__device__ __forceinline__ unsigned xb_ld(unsigned* p)              { return __hip_atomic_load(p, __ATOMIC_RELAXED, __HIP_MEMORY_SCOPE_AGENT); }
__device__ __forceinline__ unsigned xb_add(unsigned* p, unsigned v) { return __hip_atomic_fetch_add(p, v, __ATOMIC_RELAXED, __HIP_MEMORY_SCOPE_AGENT); }
__device__ __forceinline__ unsigned xb_xcc_id() { return (unsigned)__builtin_amdgcn_s_getreg((3 << 11) | 20) & 0xFu; }
#define XB_SPIN(cond, bar) do { unsigned _sp = 0; while (cond) { __builtin_amdgcn_s_sleep(1); \
    if ((++_sp & 255u) == 0u) { if (xb_ld(&(bar)[XB_TMO])) break; if (_sp > XB_SPIN_CAP) { atomicAdd(&(bar)[XB_TMO], 1u); break; } } } } while (0)
struct XcdBarrier { unsigned* bar; unsigned x; volatile LAS unsigned* st; };
__device__ __forceinline__ XcdBarrier xcd_barrier_post(unsigned* bar, volatile LAS unsigned* st) {
    XcdBarrier b; b.bar = bar; b.x = xb_xcc_id(); b.st = st;
    if (threadIdx.x == 0) (void)xb_add(&bar[XB_XCNT(b.x)], 1u);
    return b;
}
__device__ __forceinline__ void xcd_barrier_complete(unsigned* bar, unsigned x, unsigned& nloc, unsigned& nx) {
    const unsigned G = gridDim.x * gridDim.y * gridDim.z;
    unsigned sum, cnt, mine, sp = 0u;
    for (;;) {
        sum = 0u; cnt = 0u; mine = 0u;
#pragma unroll
        for (unsigned j = 0; j < 16; ++j) { const unsigned c = xb_ld(&bar[XB_XCNT(j)]); sum += c; cnt += (c > 0u) ? 1u : 0u; mine = (j == x) ? c : mine; }
        if (sum == G) break;
        __builtin_amdgcn_s_sleep(1);
        if ((++sp & 255u) == 0u) { if (xb_ld(&bar[XB_TMO])) break; if (sp > XB_SPIN_CAP) { atomicAdd(&bar[XB_TMO], 1u); break; } }
    }
    nloc = mine > 0u ? mine : 1u; nx = cnt > 0u ? cnt : 1u;
}
__device__ __forceinline__ void xcd_barrier(const XcdBarrier& b) {
    asm volatile("s_waitcnt vmcnt(0)" ::: "memory");
    __syncthreads();
    if (threadIdx.x == 0) {
        unsigned* bar = b.bar;
        __builtin_amdgcn_s_waitcnt(0);
        unsigned nloc = b.st[0], nx = b.st[1];
        if (nloc == 0u) { xcd_barrier_complete(bar, b.x, nloc, nx); b.st[0] = nloc; b.st[1] = nx; }
        const unsigned old = xb_add(&bar[XB_XSUB(b.x)], 1u);
        const unsigned gen = old / nloc;
        if (old + 1u == (gen + 1u) * nloc) {
            __builtin_amdgcn_fence(__ATOMIC_RELEASE, "agent");
            asm volatile("s_waitcnt vmcnt(0)" ::: "memory");
            const unsigned og = xb_add(&bar[XB_TOP], 1u);
            const unsigned tg = og / nx;
            if (og + 1u == (tg + 1u) * nx) xb_add(&bar[XB_TOPGEN], 1u);
            else XB_SPIN(xb_ld(&bar[XB_TOPGEN]) == tg, bar);
            __builtin_amdgcn_fence(__ATOMIC_ACQUIRE, "agent");
            xb_add(&bar[XB_XGEN(b.x)], 1u);
            asm volatile("s_waitcnt vmcnt(0)" ::: "memory");
        } else {
            XB_SPIN(xb_ld(&bar[XB_XGEN(b.x)]) == gen, bar);
            __builtin_amdgcn_fence(__ATOMIC_ACQUIRE, "agent");
            asm volatile("s_waitcnt vmcnt(0)" ::: "memory");
        }
    }
    __syncthreads();
}

__device__ __forceinline__ void grid_barrier(unsigned* ctr, unsigned target) {
    asm volatile("s_waitcnt vmcnt(0)" ::: "memory");
    __syncthreads();
    if (threadIdx.x == 0) {
        __builtin_amdgcn_fence(__ATOMIC_RELEASE, "agent");
        asm volatile("s_waitcnt vmcnt(0)" ::: "memory");
        __hip_atomic_fetch_add(ctr, 1u, __ATOMIC_RELAXED, __HIP_MEMORY_SCOPE_AGENT);
        while (__hip_atomic_load(ctr, __ATOMIC_RELAXED, __HIP_MEMORY_SCOPE_AGENT) < target) __builtin_amdgcn_s_sleep(2);
        __builtin_amdgcn_fence(__ATOMIC_ACQUIRE, "agent");
        asm volatile("s_waitcnt vmcnt(0)" ::: "memory");
    }
    __syncthreads();
}

__global__ void __launch_bounds__(NTHREADS, 2) fox_fwd(Args args) {
    extern __shared__ __attribute__((aligned(16))) unsigned char lds[];
    if (args.ph_lo < 0) cg::this_grid().sync();
#define tid ((int)threadIdx.x)
#define lane (tid & 63)
    const int wave = __builtin_amdgcn_readfirstlane(tid >> 6);
    const int G = gridDim.x, bx = blockIdx.x, vcu = (G % 8 == 0) ? (bx % 8) * (G / 8) + bx / 8 : bx;
    unsigned char* ws = args.ws;
    const float* x = args.in[0]; const float* meta = args.in[1]; const float* norm_gain = args.in[2]; const float* w_in = args.in[3];
    const float* b_f = args.in[4]; const float* conv_w = args.in[5]; const float* w_att_o = args.in[6]; const float* w_conv_o = args.in[7];
    const float* w_out = args.in[8]; const float* final_gain = args.in[9];
    bf16_t* WIN = (bf16_t*)(ws + WS_WIN); bf16_t* WATT = (bf16_t*)(ws + WS_WATT); bf16_t* WCONV = (bf16_t*)(ws + WS_WCONV); bf16_t* WOUT = (bf16_t*)(ws + WS_WOUT);
    bf16_t* XN = (bf16_t*)(ws + WS_XN); bf16_t* Qb = (bf16_t*)(ws + WS_Q); bf16_t* Kb = (bf16_t*)(ws + WS_K); bf16_t* Vb = (bf16_t*)(ws + WS_V);
    bf16_t* Zb = (bf16_t*)(ws + WS_Z); bf16_t* P1b = (bf16_t*)(ws + WS_P1); bf16_t* P2b = (bf16_t*)(ws + WS_P2); bf16_t* Rb = (bf16_t*)(ws + WS_R);
    bf16_t* S2b = (bf16_t*)(ws + WS_S2); bf16_t* AATT = (bf16_t*)(ws + WS_AATT); bf16_t* ACONV = (bf16_t*)(ws + WS_ACONV); bf16_t* MG = (bf16_t*)(ws + WS_MG);
    float* LF = (float*)(ws + WS_LF); float* SS = (float*)(ws + WS_SS);
    const int lo = args.ph_lo, hi = args.ph_hi;
    volatile LAS unsigned* xst = (volatile LAS unsigned*)((LAS unsigned char*)lds + LDS_BYTES - 64);
    if (tid < 16) xst[tid] = 0u;
    __syncthreads();
    XcdBarrier xbar; xbar.bar = (unsigned*)(ws + WS_CTL) + 8192; xbar.x = 0; xbar.st = xst;
    if (hi - lo > 1) xbar = xcd_barrier_post((unsigned*)(ws + WS_CTL) + 8192, xst);
#define IN(k) (lo <= (k) && (k) < hi)
#define SEAM(k) do { if (IN(k) && IN((k) + 1)) { xcd_barrier(xbar); } } while (0)
#define REP(k) for (int rep_ = 0; rep_ < ((PROBE_REPEAT == (k)) ? 2 : 1); ++rep_)
#define REPBAR(k) do { if (PROBE_REPEAT == (k) && rep_ == 0) grid_barrier((unsigned*)(ws + WS_CTL) + 64 * (8 + (k)), (unsigned)G); } while (0)
    const int gw = vcu * NWAVES + wave, NGW = G * NWAVES, ngt = G * NTHREADS;
#define gt (bx * NTHREADS + tid)

    if (IN(0)) REP(0) {
        LAS float* scr = (LAS float*)((LAS unsigned char*)lds + wave * 16640);
        constexpr int NG_IN = 321, I_IN = NG_IN * 32, I_SQ = 32 * 32, NITEMS = I_IN + 3 * I_SQ;
#define TR_DECODE(T_, it_) do { int r_ = (it_); if (r_ < I_IN) { const bool tail_ = r_ >= 320 * 32; const int kb = tail_ ? (r_ - 320 * 32) : (((r_ >> 1) & 3) | (((r_ >> 3) & 7) << 2)), grp = tail_ ? 320 : ((r_ & 1) | ((r_ >> 6) << 1)); T_.src = w_in + (size_t)(kb * 64) * N_IN + src_col_of_dst(grp * 64); T_.dst = WIN + (size_t)(grp * 64) * 2048 + kb * 64; T_.ldn = N_IN; T_.nvalid4 = (grp == 320) ? 4 : 16; } \
            else { r_ -= I_IN; const int which = r_ / I_SQ; r_ -= which * I_SQ; const int kb = ((r_ >> 1) & 3) | (((r_ >> 3) & 7) << 2), grp = (r_ & 1) | ((r_ >> 6) << 1); T_.src = (which == 0 ? w_att_o : which == 1 ? w_conv_o : w_out) + (size_t)(kb * 64) * DM + grp * 64; \
                   T_.dst = (which == 0 ? WATT : which == 1 ? WCONV : WOUT) + (size_t)(grp * 64) * 2048 + kb * 64; T_.ldn = DM; T_.nvalid4 = 16; } } while (0)
        {
            f32x4 va[16], vb[16]; TrItem ta, tb; int it = gw;
            if (it < NITEMS) { TR_DECODE(ta, it); tr_load(va, ta, lane); }
            while (it < NITEMS) {
                int it2 = it + NGW; if (it2 < NITEMS) { TR_DECODE(tb, it2); tr_load(vb, tb, lane); }
                tr_process(va, ta, scr, lane);
                it = it2; if (it >= NITEMS) break;
                it2 = it + NGW; if (it2 < NITEMS) { TR_DECODE(ta, it2); tr_load(va, ta, lane); }
                tr_process(vb, tb, scr, lane);
                it = it2;
            }
        }
#undef TR_DECODE
        for (int m = gw; m < MREAL + NMETA; m += 2 * NGW) { const int m2 = m + NGW;
            rms_rows2_to_bf16(m < MREAL ? x + (size_t)m * DM : meta + (size_t)(m - MREAL) * DM, XN + (size_t)m * DM,
                              m2 < MREAL ? x + (size_t)m2 * DM : meta + (size_t)(m2 - MREAL) * DM, XN + (size_t)m2 * DM, m2 < MREAL + NMETA, norm_gain, lane); }
        for (int bh = 0; bh < NB * NH; ++bh) { zero_bytes16(Kb + (size_t)bh * KVROWS * HD, (size_t)48 * HD * 2, gt, ngt); zero_bytes16(Vb + (size_t)bh * KVROWS * HD, (size_t)48 * HD * 2, gt, ngt); }
        REPBAR(0);
    }
    SEAM(0);
    if (IN(1)) REP(1) {
        pg8::Gemm g{XN, WIN, nullptr, nullptr, MREAL, 20480, DM}; pg8::StaticOrder<1> S; S.init(MREAL, 20480, G, bx);
        pg8::EpiProj E{Qb, Kb, Vb, Zb, P1b, P2b, Rb, S2b};
        pg8::gemm_phase<pg8::EpiProj, pg8::StaticOrder<1>, 1>((LAS unsigned char*)lds, g, S, E);
        for (int srep = 0; srep < SIDE_REPS; ++srep) for (int c = bx; c < 256; c += G) p1_side_task(c, (LAS unsigned char*)lds, XN, WIN, b_f, LF, Kb, Vb, P1b);
        REPBAR(1);
    }
    SEAM(1);
    if (IN(2)) REP(2) {
        const att::Tensors T{Qb, Kb, Vb, Zb, AATT, LF};
        att::attn_phase((char*)lds, T, vcu, G);
        {
            const int ch = (tid & 255) * 8, rsub = tid >> 8, rows_per = MREAL / G;
            const f32x4 w0a = *(const f32x4*)(conv_w + ch), w0b = *(const f32x4*)(conv_w + ch + 4), w1a = *(const f32x4*)(conv_w + DM + ch), w1b = *(const f32x4*)(conv_w + DM + ch + 4),
                        w2a = *(const f32x4*)(conv_w + 2 * DM + ch), w2b = *(const f32x4*)(conv_w + 2 * DM + ch + 4);
#define CONV2(W, A0, A1, A2, GW, wa, wb, wc_, j0) W = cvt_pk_bf16(bf_lo(GW) * (wa[j0] * bf_lo(A0) + wb[j0] * bf_lo(A1) + wc_[j0] * bf_lo(A2)), bf_hi(GW) * (wa[j0 + 1] * bf_hi(A0) + wb[j0 + 1] * bf_hi(A1) + wc_[j0 + 1] * bf_hi(A2)))
            const bool band = (MREAL % G == 0) && ((MREAL / G) % 2 == 0);
            const int r_begin = band ? vcu * rows_per + rsub : (gt >> 8), r_end = band ? (vcu + 1) * rows_per : MREAL, r_step = band ? 2 : (ngt >> 8);
            for (int row = r_begin; row < r_end; row += r_step) {
                const int b = row >> 12; const size_t pr = (size_t)(row + 2 * b) * DM + ch;
                const u32x4 a0 = *(const u32x4*)(P1b + pr), a1 = *(const u32x4*)(P1b + pr + DM), a2 = *(const u32x4*)(P1b + pr + 2 * DM), gg = *(const u32x4*)(P2b + (size_t)row * DM + ch);
                u32x4 o;
                CONV2(o.x, a0.x, a1.x, a2.x, gg.x, w0a, w1a, w2a, 0); CONV2(o.y, a0.y, a1.y, a2.y, gg.y, w0a, w1a, w2a, 2);
                CONV2(o.z, a0.z, a1.z, a2.z, gg.z, w0b, w1b, w2b, 0); CONV2(o.w, a0.w, a1.w, a2.w, gg.w, w0b, w1b, w2b, 2);
                *(u32x4*)(ACONV + (size_t)row * DM + ch) = o;
            }
#undef CONV2
        }
        REPBAR(2);
    }
    SEAM(2);
    if (IN(3)) REP(3) {
        pg8::Gemm g{AATT, WATT, ACONV, WCONV, MREAL, DM, DM}; pg8::StaticOrder<2> S; S.init(MREAL, DM, G, bx);
        pg8::EpiMerge E{Rb, S2b, MG};
        pg8::gemm_phase<pg8::EpiMerge, pg8::StaticOrder<2>, 2>((LAS unsigned char*)lds, g, S, E);
        REPBAR(3);
    }
    SEAM(3);
    const bool fused_norm = (G == 256) && IN(4) && IN(5);
    if (IN(4)) {
        pg8::Gemm g{MG, WOUT, nullptr, nullptr, MREAL, DM, DM}; pg8::StaticOrder<1> S; S.init(MREAL, DM, G, bx);
        if (fused_norm) { pg8::EpiOutNorm E{x, args.out, final_gain, SS, (unsigned*)(ws + WS_CTL) + 2048};
            pg8::gemm_phase<pg8::EpiOutNorm, pg8::StaticOrder<1>, 1, false, true>((LAS unsigned char*)lds, g, S, E); }
        else { pg8::EpiOut E{x, args.out, SS};
            pg8::gemm_phase<pg8::EpiOut, pg8::StaticOrder<1>, 1>((LAS unsigned char*)lds, g, S, E); }
    }
    if (!fused_norm) {
    SEAM(4);
    if (IN(5)) {
        for (int m = gw; m < MREAL; m += NGW) {
            float s = (lane < 32) ? SS[(size_t)m * 32 + lane] : 0.f; s = wave_sum(s);
            const float rstd = 1.0f / sqrtf(s * (1.f / DM) + EPS);
            f32x4* o = (f32x4*)(args.out + (size_t)m * DM) + lane; const f32x4* gr = (const f32x4*)final_gain + lane;
#pragma unroll
            for (int j = 0; j < 8; ++j) { const f32x4 y = o[64 * j]; o[64 * j] = y * rstd * gr[64 * j]; }
        }
    }
    }
#undef IN
#undef SEAM
#undef REP
#undef REPBAR
#undef tid
#undef lane
#undef gt
}

extern "C" void kernel_launch(void* const* d_in, const int* in_sizes, int n_in, void* d_out, int out_size, void* d_ws, size_t ws_size, hipStream_t stream) {
    static int grid = 0;
    if (grid == 0) {
        if (n_in != 10 || in_sizes[0] != MREAL * DM || out_size != MREAL * DM || ws_size < WS_END) {
            fprintf(stderr, "kernel_launch: unexpected shapes (n_in %d, in0 %d, out %d, ws %zu < %zu?)\n", n_in, n_in > 0 ? in_sizes[0] : -1, out_size, ws_size, (size_t)WS_END); grid = -1; return; }
        int dev = 0, cus = 0, per_cu = 0;
        (void)hipGetDevice(&dev); (void)hipDeviceGetAttribute(&cus, hipDeviceAttributeMultiprocessorCount, dev);
        if (hipFuncSetAttribute((const void*)fox_fwd, hipFuncAttributeMaxDynamicSharedMemorySize, LDS_BYTES) != hipSuccess) { fprintf(stderr, "kernel_launch: hipFuncSetAttribute failed\n"); grid = -1; return; }
        if (hipOccupancyMaxActiveBlocksPerMultiprocessor(&per_cu, (const void*)fox_fwd, NTHREADS, LDS_BYTES) != hipSuccess || per_cu < 1) { fprintf(stderr, "kernel_launch: occupancy query says %d\n", per_cu); per_cu = 1; }
        (void)hipGetLastError();
        if (cus <= 0) cus = 256;
        grid = cus;
    }
    if (grid < 0) return;
    Args a{};
    for (int i = 0; i < 10; ++i) a.in[i] = (const float*)d_in[i];
    a.out = (float*)d_out; a.ws = (unsigned char*)d_ws;
#if MK_COOP
    a.ph_lo = 0; a.ph_hi = 6;
    (void)hipMemsetAsync((unsigned char*)d_ws + WS_CTL, 0, 65536, stream);
    void* kargs[] = {&a};
    hipError_t e = hipLaunchCooperativeKernel((const void*)fox_fwd, dim3(grid), dim3(NTHREADS), kargs, LDS_BYTES, stream);
    if (e != hipSuccess) fprintf(stderr, "kernel_launch: cooperative launch failed: %s (grid %d)\n", hipGetErrorString(e), grid);
#else
    for (int p = 0; p < 6; ++p) { a.ph_lo = p; a.ph_hi = p + 1; hipLaunchKernelGGL(fox_fwd, dim3(grid), dim3(NTHREADS), LDS_BYTES, stream, a); }
#endif
}
```
